# Optimizing an MI355X kernel written in HIP

```python
import jax, jax.numpy as jnp
from jax import lax
import numpy as np

D_MODEL = 1024
BATCH = 8
SEQ = 4096
DEPTH = 2

N_MEM = 256
N_BRANCH = 4
GROUP_W = D_MODEL // N_BRANCH
N_SUB = 4
HEAD_DIM = GROUP_W // N_SUB
CHUNK = 128
GRID_W = 64
WIN_H_MAX = 8
WIN_W = 16
N_IN_SLOTS = 11
IN_COLS = N_IN_SLOTS * GROUP_W
EPS = 1e-6

kernel_name = "hybrid_parallel_gmlp_natten_fnet_memattn"


def rmsnorm(x, g):
    xf = x.astype(jnp.float32)
    y = xf * lax.rsqrt(jnp.mean(xf * xf, axis=-1, keepdims=True) + EPS)
    return (y * g.astype(jnp.float32)).astype(x.dtype)


def layernorm(x, g, b):
    xf = x.astype(jnp.float32)
    mu = jnp.mean(xf, axis=-1, keepdims=True)
    var = jnp.mean(jnp.square(xf - mu), axis=-1, keepdims=True)
    y = (xf - mu) * lax.rsqrt(var + EPS)
    return (y * g.astype(jnp.float32) + b.astype(jnp.float32)).astype(x.dtype)


def split_heads(x):
    return x.reshape(x.shape[:-1] + (N_SUB, HEAD_DIM))


def chunked_spatial_gating(u, v, ln_g, ln_b, w_s, b_s):
    B, S, _ = u.shape
    n_chunks = S // CHUNK
    vn = layernorm(v, ln_g, ln_b).reshape(B, n_chunks, CHUNK, N_SUB, HEAD_DIM)
    s = jnp.einsum('hpq,bnqhd->bnphd', w_s, vn) + b_s.T[None, None, :, :, None]
    return u * s.reshape(B, S, GROUP_W)


def neighbourhood_attention(q, k, v, qn_g, kn_g, rpb):
    B, S, _ = q.shape
    rows = S // GRID_W
    kh = min(WIN_H_MAX, rows)
    q = rmsnorm(split_heads(q), qn_g) * (HEAD_DIM ** -0.5)
    k = rmsnorm(split_heads(k), kn_g)
    v = split_heads(v)
    q = q.reshape(B, rows, GRID_W, N_SUB, HEAD_DIM)
    k = k.reshape(B, rows, GRID_W, N_SUB, HEAD_DIM)
    v = v.reshape(B, rows, GRID_W, N_SUB, HEAD_DIM)
    r = jnp.arange(rows)
    row_start = jnp.clip(r - kh // 2, 0, rows - kh)
    row_idx = row_start[:, None] + jnp.arange(kh)
    kg = k[:, row_idx]
    vg = v[:, row_idx]
    scores = jnp.einsum('brchd,brkwhd->bhrckw', q, kg).astype(jnp.float32)
    c = jnp.arange(GRID_W)
    col_start = jnp.clip(c - WIN_W // 2, 0, GRID_W - WIN_W)
    col_ok = (c[None, :] >= col_start[:, None]) & (c[None, :] < col_start[:, None] + WIN_W)
    d_row = row_idx - r[:, None] + (WIN_H_MAX - 1)
    d_col = jnp.clip(c[None, :] - c[:, None] + (WIN_W - 1), 0, 2 * WIN_W - 2)
    bias = rpb[:, d_row[:, None, :, None], d_col[None, :, None, :]]
    scores = scores + bias[None].astype(jnp.float32)
    scores = jnp.where(col_ok[None, None, None, :, None, :], scores, -jnp.inf)
    shp = scores.shape
    p = jax.nn.softmax(scores.reshape(shp[:4] + (kh * GRID_W,)), axis=-1).reshape(shp).astype(v.dtype)
    out = jnp.einsum('bhrckw,brkwhd->brchd', p, vg)
    return out.reshape(B, S, GROUP_W)


def fourier_mixing(f, w_f):
    B, S, _ = f.shape
    fg = f.astype(jnp.float32).reshape(B, S, N_SUB, HEAD_DIM)
    z = jnp.fft.fft2(fg, axes=(1, 3), norm='ortho').real.astype(f.dtype)
    return jnp.einsum('bshd,hde->bshe', z, w_f).reshape(B, S, GROUP_W)


def memory_attention(q, mem_n, w_mkv, qn_g, kn_g):
    B, S, _ = q.shape
    km, vm = jnp.split(mem_n @ w_mkv, 2, axis=-1)
    q = rmsnorm(split_heads(q), qn_g) * (HEAD_DIM ** -0.5)
    km = rmsnorm(split_heads(km), kn_g)
    vm = split_heads(vm)
    s = jnp.einsum('bshd,bmhd->bhsm', q, km).astype(jnp.float32)
    p = jax.nn.softmax(s, axis=-1).astype(vm.dtype)
    return jnp.einsum('bhsm,bmhd->bshd', p, vm).reshape(B, S, GROUP_W)


def setup_inputs(seed: int = 0) -> dict:
    key = jax.random.key(seed)
    ks = jax.random.split(key, 20)
    nrm = lambda k, shp: jax.random.normal(k, shp, jnp.float32)
    return {
        "x": nrm(ks[0], (BATCH, SEQ, D_MODEL)),
        "mem": nrm(ks[1], (BATCH, N_MEM, D_MODEL)),
        "norm_g": 1.0 + 0.02 * nrm(ks[2], (DEPTH, D_MODEL)),
        "w_in": nrm(ks[3], (DEPTH, D_MODEL, IN_COLS)) * D_MODEL ** -0.5,
        "w_out": nrm(ks[4], (DEPTH, D_MODEL, D_MODEL)) * D_MODEL ** -0.5,
        "gm_ln_g": 1.0 + 0.02 * nrm(ks[5], (DEPTH, GROUP_W)),
        "gm_ln_b": 0.02 * nrm(ks[6], (DEPTH, GROUP_W)),
        "gm_w_s": nrm(ks[7], (DEPTH, N_SUB, CHUNK, CHUNK)) * 0.5 * CHUNK ** -0.5,
        "gm_b_s": 1.0 + 0.02 * nrm(ks[8], (DEPTH, N_SUB, CHUNK)),
        "na_qn_g": 1.0 + 0.02 * nrm(ks[9], (DEPTH, HEAD_DIM)),
        "na_kn_g": 1.0 + 0.02 * nrm(ks[10], (DEPTH, HEAD_DIM)),
        "na_rpb": 0.1 * nrm(ks[11], (DEPTH, N_SUB, 2 * WIN_H_MAX - 1, 2 * WIN_W - 1)),
        "fn_w": nrm(ks[12], (DEPTH, N_SUB, HEAD_DIM, HEAD_DIM)) * HEAD_DIM ** -0.5,
        "mem_norm_g": 1.0 + 0.02 * nrm(ks[13], (DEPTH, D_MODEL)),
        "mem_w_kv": nrm(ks[14], (DEPTH, D_MODEL, 2 * GROUP_W)) * D_MODEL ** -0.5,
        "mem_qn_g": 1.0 + 0.02 * nrm(ks[15], (DEPTH, HEAD_DIM)),
        "mem_kn_g": 1.0 + 0.02 * nrm(ks[16], (DEPTH, HEAD_DIM)),
    }


def reference(x, mem, norm_g, w_in, w_out, gm_ln_g, gm_ln_b, gm_w_s, gm_b_s,
              na_qn_g, na_kn_g, na_rpb, fn_w, mem_norm_g, mem_w_kv, mem_qn_g, mem_kn_g):
    for l in range(DEPTH):
        h = rmsnorm(x, norm_g[l])
        proj = h @ w_in[l]
        a_u, a_v, a_g, b_q, b_k, b_v, b_g, c_in, c_g, d_q, d_g = jnp.split(proj, N_IN_SLOTS, axis=-1)
        y_a = chunked_spatial_gating(a_u, a_v, gm_ln_g[l], gm_ln_b[l], gm_w_s[l], gm_b_s[l]) * jax.nn.silu(a_g)
        y_b = neighbourhood_attention(b_q, b_k, b_v, na_qn_g[l], na_kn_g[l], na_rpb[l]) * jax.nn.silu(b_g)
        y_c = fourier_mixing(c_in, fn_w[l]) * jax.nn.silu(c_g)
        mem_n = rmsnorm(mem, mem_norm_g[l])
        y_d = memory_attention(d_q, mem_n, mem_w_kv[l], mem_qn_g[l], mem_kn_g[l]) * jax.nn.silu(d_g)
        y = jnp.concatenate([y_a, y_b, y_c, y_d], axis=-1) @ w_out[l]
        x = x + y
    return x
```

```cpp
#include <hip/hip_runtime.h>
#include <cstdio>
#include <cstdint>
#include <cmath>
namespace pg8 {
#define PG8_LAS __attribute__((address_space(3)))
typedef unsigned short bf16_t;
typedef short bf16x8 __attribute__((ext_vector_type(8)));
typedef float f32x4 __attribute__((ext_vector_type(4)));
typedef unsigned u32x4 __attribute__((ext_vector_type(4)));
constexpr int BM = 256, BK = 64, HALF = 128, HTB = HALF * BK * 2  , STAGE_BYTES = 8 * HTB, NXCD = 8, WGM = 8;

__host__ __device__ __forceinline__ int lds_byte(int r, int c) { const int st = (r >> 4) * 2 + (c >> 5), rr = r & 15, cc = c & 31, ob = rr * 64 + cc * 2; return st * 1024 + (ob ^ (((ob >> 9) & 1) << 5)); }
__host__ __device__ __forceinline__ void stage_rc(int b, int& R, int& C) { const int st = b / 1024, sb = b % 1024, swz = sb ^ (((sb >> 9) & 1) << 5); R = (st >> 1) * 16 + swz / 64; C = (st & 1) * 32 + (swz % 64) / 2; }
__host__ __device__ __forceinline__ int perm32(int rho) { const int n = rho >> 4, i = rho & 15; return 8 * (i >> 2) + 4 * n + (i & 3); }

struct Unit { int pm, pn; };
struct Gemm { const bf16_t* A; const bf16_t* Bt; int M, N, K; };

struct StaticOrder {
    int nM, nN, nwg, G, c;
    __host__ __device__ void init(int M, int N, int G_, int c_) { nM = M / BM; nN = N / BM; nwg = nM * nN; G = G_; c = c_; }
    __host__ __device__ bool next(int i, Unit& u) const {
        const long L = (long)i * G + c; if (L >= nwg) return false;
        int wgid = (int)L; { const int q = nwg / NXCD, r = nwg % NXCD, xcd = wgid % NXCD, off = wgid / NXCD; wgid = (xcd < r ? xcd * (q + 1) : r * (q + 1) + (xcd - r) * q) + off; }
        const int nig = WGM * nN, gid = wgid / nig, fm = gid * WGM, gsz = (nM - fm) < WGM ? (nM - fm) : WGM;
        u.pm = fm + ((wgid % nig) % gsz); u.pn = (wgid % nig) / gsz; return true;
    }
    __device__ __forceinline__ void a_ready(const Unit&) const {}
    __device__ __forceinline__ void done(const Unit&) const {}
};

__device__ __forceinline__ unsigned cvt_pk_bf16(float lo, float hi) { unsigned r; asm volatile("v_cvt_pk_bf16_f32 %0, %1, %2" : "=v"(r) : "v"(lo), "v"(hi)); return r; }
typedef float f32x2 __attribute__((ext_vector_type(2)));
typedef unsigned u32x2 __attribute__((ext_vector_type(2)));
struct EpiProj {
    static constexpr bool PERM = true, AFTER_DRAIN = false;
    bf16_t* O; int ldc;
    const float* part;
    const float* g0; const float* g1; const float* g2;
    int t0, t1, t2; float s0, s1, s2;
    __device__ __forceinline__ void operator()(const f32x4 (&acc)[2][2][4][2], const Unit& u, int wr, int wc, int fr, int fq) const {
        const float* gp = nullptr; float sc = 1.f;
        if (u.pn == t0) { gp = g0; sc = s0; } else if (u.pn == t1) { gp = g1; sc = s1; } else if (u.pn == t2) { gp = g2; sc = s2; }
        f32x4 gv[2][2];
#pragma unroll
        for (int bj = 0; bj < 2; ++bj)
#pragma unroll
            for (int n = 0; n < 2; ++n) gv[bj][n] = gp ? *(const f32x4*)(gp + 32 * bj + 8 * fq + 4 * n) : (f32x4){1.f, 1.f, 1.f, 1.f};
        const int row0 = u.pm * BM + wr * 64 + fr, col0 = u.pn * BM + 64 * wc + 8 * fq;
#pragma unroll
        for (int ai = 0; ai < 2; ++ai)
#pragma unroll
            for (int m = 0; m < 4; ++m) {
                const int row = row0 + ai * HALF + m * 16;
                float rs = 1.f;
                if (part) { const f32x4 p4 = *(const f32x4*)(part + (size_t)row * 16 + 4 * fq); float t = (p4[0] + p4[1]) + (p4[2] + p4[3]);
                    t += __shfl_xor(t, 16); t += __shfl_xor(t, 32); rs = 1.0f / sqrtf(t * (1.0f / 1024.0f) + 1e-6f); }
                f32x4 v[2][2];
#pragma unroll
                for (int bj = 0; bj < 2; ++bj)
#pragma unroll
                    for (int n = 0; n < 2; ++n) v[bj][n] = acc[ai][bj][m][n] * rs;
                if (gp) {
                    float ss = 0.f;
#pragma unroll
                    for (int bj = 0; bj < 2; ++bj)
#pragma unroll
                        for (int n = 0; n < 2; ++n) { const f32x4 x = v[bj][n]; ss += (x[0] * x[0] + x[1] * x[1]) + (x[2] * x[2] + x[3] * x[3]); }
                    ss += __shfl_xor(ss, 16); ss += __shfl_xor(ss, 32);
                    const float hr = sc / sqrtf(ss * (1.0f / 64.0f) + 1e-6f);
#pragma unroll
                    for (int bj = 0; bj < 2; ++bj)
#pragma unroll
                        for (int n = 0; n < 2; ++n) v[bj][n] = v[bj][n] * gv[bj][n] * hr;
                }
                bf16_t* rowp = O + (size_t)row * ldc + col0;
#pragma unroll
                for (int bj = 0; bj < 2; ++bj) { u32x4 w; w.x = cvt_pk_bf16(v[bj][0][0], v[bj][0][1]); w.y = cvt_pk_bf16(v[bj][0][2], v[bj][0][3]); w.z = cvt_pk_bf16(v[bj][1][0], v[bj][1][1]); w.w = cvt_pk_bf16(v[bj][1][2], v[bj][1][3]);
                    *(u32x4*)(rowp + 32 * bj) = w; }
            }
    }
};
struct EpiOut {
    static constexpr bool PERM = false, AFTER_DRAIN = false;
    const float* base; float* out; bf16_t* xb; float* part; int ldc;
    __device__ __forceinline__ void operator()(const f32x4 (&acc)[2][2][4][2], const Unit& u, int wr, int wc, int fr, int fq) const {
        const int col0 = u.pn * BM + wc * 32 + 4 * fq;
#pragma unroll
        for (int ai = 0; ai < 2; ++ai)
#pragma unroll
            for (int m = 0; m < 4; ++m) { const int row = u.pm * BM + ai * HALF + wr * 64 + m * 16 + fr; const size_t off = (size_t)row * ldc + col0; float ss = 0.f;
#pragma unroll
                for (int bj = 0; bj < 2; ++bj)
#pragma unroll
                    for (int n = 0; n < 2; ++n) { const f32x4 bs = *(const f32x4*)(base + off + bj * HALF + n * 16); const f32x4 o = bs + acc[ai][bj][m][n];
                        *(f32x4*)(out + off + bj * HALF + n * 16) = o;
                        if (xb) { u32x2 w; w.x = cvt_pk_bf16(o[0], o[1]); w.y = cvt_pk_bf16(o[2], o[3]); *(u32x2*)(xb + off + bj * HALF + n * 16) = w;
                            ss += (o[0] * o[0] + o[1] * o[1]) + (o[2] * o[2] + o[3] * o[3]); } }
                if (xb) { ss += __shfl_xor(ss, 16); ss += __shfl_xor(ss, 32); if (fq == 0) part[(size_t)row * 16 + u.pn * 4 + wc] = ss; }
            }
    }
};
template <class Epi, class Sched, bool ALIGN_EPI = false, bool SP2 = false>
__device__ __forceinline__ void gemm_phase(PG8_LAS unsigned char* lds, const Gemm g, const Sched& S, const Epi& E) {
    int tid_ = threadIdx.x; asm volatile("" : "+v"(tid_));
    const int tid = tid_, wid = __builtin_amdgcn_readfirstlane(tid >> 6), lane = tid & 63, wr = wid >> 2, wc = wid & 3, fr = lane & 15, fq = lane >> 4;
    const int K = g.K, nt = K / BK;
    unsigned voffA[2], voffB[2];
#pragma unroll
    for (int i = 0; i < 2; ++i) { int R, C; stage_rc(tid * 16 + i * 8192, R, C); const int Rb = Epi::PERM ? ((R & ~31) + perm32(R & 31)) : R;
        voffA[i] = (unsigned)(R * K + C) * 2u; voffB[i] = (unsigned)(Rb * K + C) * 2u; }
    const size_t kstep = (size_t)(BK * 2);
    const size_t hstep = (size_t)HALF * K * 2;
    const size_t tstep = 2 * hstep;
    const unsigned ldsw = (unsigned)wid * 1024u;
    const int aoff = lds_byte(wr * 64 + fr, fq * 8), boff = lds_byte(wc * 32 + fr, fq * 8);
#define PG8_SA(b, h) (((b) * 2 + (h)) * HTB)
#define PG8_SB(b, h) ((4 + (b) * 2 + (h)) * HTB)
#define PG8_STAGE(bufoff, gbase, voff) do { _Pragma("unroll") for (int _i = 0; _i < 2; ++_i) \
        __builtin_amdgcn_global_load_lds((const unsigned*)((const char*)(gbase) + (voff)[_i]), (PG8_LAS unsigned*)(lds + (bufoff) + ldsw + _i * 8192), 16, 0, 0); } while (0)
#define PG8_LDA(dst, b, h) do { _Pragma("unroll") for (int m = 0; m < 4; ++m) _Pragma("unroll") for (int k = 0; k < 2; ++k) dst[m][k] = *(const PG8_LAS bf16x8*)(lds + PG8_SA(b, h) + aoff + m * 2048 + k * 1024); } while (0)
#define PG8_LDB(dst, b, h) do { _Pragma("unroll") for (int n = 0; n < 2; ++n) _Pragma("unroll") for (int k = 0; k < 2; ++k) dst[n][k] = *(const PG8_LAS bf16x8*)(lds + PG8_SB(b, h) + boff + n * 2048 + k * 1024); } while (0)
#define PG8_MMA(ai, bj, At, Bt) do { __builtin_amdgcn_s_setprio(1); _Pragma("unroll") for (int m = 0; m < 4; ++m) _Pragma("unroll") for (int n = 0; n < 2; ++n) _Pragma("unroll") for (int k = 0; k < 2; ++k) \
        acc[ai][bj][m][n] = __builtin_amdgcn_mfma_f32_16x16x32_bf16(Bt[n][k], At[m][k], acc[ai][bj][m][n], 0, 0, 0); __builtin_amdgcn_s_setprio(0); } while (0)
#define PG8_WAIT_V(n) asm volatile("s_waitcnt vmcnt(" #n ")" ::: "memory")
#define PG8_WAIT_L(n) asm volatile("s_waitcnt lgkmcnt(" #n ")" ::: "memory")
#define PG8_BAR __builtin_amdgcn_s_barrier()
#define PG8_SCHED __builtin_amdgcn_sched_barrier(0)
    Unit cur, nxt; int ui = 0;
    if (!S.next(0, cur)) return;
    f32x4 acc[2][2][4][2];
#pragma unroll
    for (int a = 0; a < 2; ++a)
#pragma unroll
        for (int b = 0; b < 2; ++b)
#pragma unroll
            for (int m = 0; m < 4; ++m)
#pragma unroll
                for (int n = 0; n < 2; ++n) acc[a][b][m][n] = (f32x4){0.f, 0.f, 0.f, 0.f};
    bf16x8 At[4][2], B0[2][2], B1[2][2];
    const char* cA = (const char*)g.A + (size_t)cur.pm * tstep; const char* cB = (const char*)g.Bt + (size_t)cur.pn * tstep;
    S.a_ready(cur);
    if constexpr (SP2) {
        PG8_STAGE(PG8_SB(0, 0), cB, voffB); PG8_STAGE(PG8_SB(0, 1), cB + hstep, voffB); PG8_STAGE(PG8_SA(0, 0), cA, voffA); PG8_STAGE(PG8_SA(0, 1), cA + hstep, voffA);
        if (wr == 1) PG8_BAR;
        PG8_WAIT_V(2); PG8_BAR;
        PG8_STAGE(PG8_SB(1, 0), cB + kstep, voffB); PG8_STAGE(PG8_SA(1, 0), cA + kstep, voffA); PG8_STAGE(PG8_SB(1, 1), cB + hstep + kstep, voffB);
        PG8_WAIT_V(6); PG8_BAR;
    } else {
        PG8_STAGE(PG8_SB(0, 0), cB, voffB); PG8_STAGE(PG8_SA(0, 0), cA, voffA); PG8_STAGE(PG8_SB(0, 1), cB + hstep, voffB); PG8_STAGE(PG8_SA(0, 1), cA + hstep, voffA);
        if (wr == 1) PG8_BAR;
        PG8_WAIT_V(4); PG8_BAR;
        PG8_STAGE(PG8_SB(1, 0), cB + kstep, voffB); PG8_STAGE(PG8_SA(1, 0), cA + kstep, voffA); PG8_STAGE(PG8_SB(1, 1), cB + hstep + kstep, voffB);
        PG8_WAIT_V(6); PG8_BAR;
    }
    for (;;) {
        const bool has_next = S.next(ui + 1, nxt);
        const char* nA = has_next ? (const char*)g.A + (size_t)nxt.pm * tstep : cA; const char* nB = has_next ? (const char*)g.Bt + (size_t)nxt.pn * tstep : cB;
        for (int t = 0; t < nt; t += 2) {
            const bool last = (t == nt - 2);
            const char* a1 = cA + (size_t)(t + 1) * kstep;
            const char* a2 = last ? nA : cA + (size_t)(t + 2) * kstep; const char* b2 = last ? nB : cB + (size_t)(t + 2) * kstep;
            const char* a3 = a2 + kstep; const char* b3 = b2 + kstep;
            if (last && has_next) S.a_ready(nxt);
            if constexpr (SP2) {
            PG8_LDB(B0, 0, 0); PG8_LDB(B1, 0, 1); PG8_SCHED; PG8_LDA(At, 0, 0); PG8_STAGE(PG8_SA(1, 1), a1 + hstep, voffA);
            PG8_WAIT_V(8); PG8_WAIT_L(0); PG8_BAR; PG8_MMA(0, 0, At, B0); PG8_MMA(0, 1, At, B1); PG8_BAR; PG8_SCHED;
            PG8_LDA(At, 0, 1); PG8_STAGE(PG8_SB(0, 0), b2, voffB); PG8_STAGE(PG8_SB(0, 1), b2 + hstep, voffB); PG8_STAGE(PG8_SA(0, 0), a2, voffA);
            PG8_WAIT_V(8); PG8_WAIT_L(0); PG8_BAR; PG8_MMA(1, 0, At, B0); PG8_MMA(1, 1, At, B1); PG8_BAR; PG8_SCHED;
            PG8_LDB(B0, 1, 0); PG8_LDB(B1, 1, 1); PG8_SCHED; PG8_LDA(At, 1, 0); PG8_STAGE(PG8_SA(0, 1), a2 + hstep, voffA);
            PG8_WAIT_V(8); PG8_WAIT_L(0); PG8_BAR; PG8_MMA(0, 0, At, B0); PG8_MMA(0, 1, At, B1); PG8_BAR; PG8_SCHED;
            PG8_LDA(At, 1, 1); PG8_STAGE(PG8_SB(1, 0), b3, voffB); PG8_STAGE(PG8_SB(1, 1), b3 + hstep, voffB); PG8_STAGE(PG8_SA(1, 0), a3, voffA);
            PG8_WAIT_V(8); PG8_WAIT_L(0); PG8_BAR; PG8_MMA(1, 0, At, B0); PG8_MMA(1, 1, At, B1); PG8_BAR; PG8_SCHED;
            } else {
            PG8_LDB(B0, 0, 0); PG8_SCHED; PG8_LDA(At, 0, 0); PG8_STAGE(PG8_SA(1, 1), a1 + hstep, voffA);
            PG8_WAIT_L(8); PG8_BAR; PG8_WAIT_L(0); PG8_MMA(0, 0, At, B0); PG8_BAR; PG8_SCHED;
            PG8_LDB(B1, 0, 1); PG8_STAGE(PG8_SB(0, 0), b2, voffB);
            PG8_BAR; PG8_WAIT_L(0); PG8_MMA(0, 1, At, B1); PG8_BAR;
            PG8_LDA(At, 0, 1); PG8_STAGE(PG8_SA(0, 0), a2, voffA);
            PG8_BAR; PG8_WAIT_L(0); PG8_MMA(1, 0, At, B0); PG8_BAR; PG8_SCHED;
            PG8_STAGE(PG8_SB(0, 1), b2 + hstep, voffB);
            PG8_WAIT_V(6); PG8_BAR; PG8_MMA(1, 1, At, B1); PG8_BAR;
            PG8_LDB(B0, 1, 0); PG8_SCHED; PG8_LDA(At, 1, 0); PG8_STAGE(PG8_SA(0, 1), a2 + hstep, voffA);
            PG8_WAIT_L(8); PG8_BAR; PG8_WAIT_L(0); PG8_MMA(0, 0, At, B0); PG8_BAR; PG8_SCHED;
            PG8_LDB(B1, 1, 1); PG8_STAGE(PG8_SB(1, 0), b3, voffB);
            PG8_BAR; PG8_WAIT_L(0); PG8_MMA(0, 1, At, B1); PG8_BAR;
            PG8_LDA(At, 1, 1); PG8_STAGE(PG8_SA(1, 0), a3, voffA);
            PG8_BAR; PG8_WAIT_L(0); PG8_MMA(1, 0, At, B0); PG8_BAR; PG8_SCHED;
            PG8_STAGE(PG8_SB(1, 1), b3 + hstep, voffB);
            PG8_WAIT_V(6); PG8_BAR; PG8_MMA(1, 1, At, B1); PG8_BAR;
            }
        }
        if constexpr (ALIGN_EPI) { if (wr == 0) PG8_BAR; }
        if constexpr (!Epi::AFTER_DRAIN) { E(acc, cur, wr, wc, fr, fq); S.done(cur); }
        if (!has_next) break;
#pragma unroll
        for (int a = 0; a < 2; ++a)
#pragma unroll
            for (int b = 0; b < 2; ++b)
#pragma unroll
                for (int m = 0; m < 4; ++m)
#pragma unroll
                    for (int n = 0; n < 2; ++n) acc[a][b][m][n] = (f32x4){0.f, 0.f, 0.f, 0.f};
        cur = nxt; cA = nA; cB = nB; ++ui;
        if constexpr (ALIGN_EPI) { if (wr == 1) PG8_BAR; }
    }
    PG8_WAIT_V(0);
    if constexpr (!ALIGN_EPI) { if (wr == 0) PG8_BAR; }
    PG8_BAR;
    if constexpr (Epi::AFTER_DRAIN) { E.fused(acc, cur, wr, wc, fr, fq, lds, wid, lane); S.done(cur); }
#undef PG8_SA
#undef PG8_SB
#undef PG8_STAGE
#undef PG8_LDA
#undef PG8_LDB
#undef PG8_MMA
#undef PG8_WAIT_V
#undef PG8_WAIT_L
#undef PG8_BAR
#undef PG8_SCHED
}
}
#define GAS __attribute__((address_space(1)))
#define LAS __attribute__((address_space(3)))
typedef unsigned short bf16;
typedef unsigned v4u __attribute__((ext_vector_type(4)));
typedef float f32x4 __attribute__((ext_vector_type(4)));
typedef short bf16x8 __attribute__((ext_vector_type(8)));
typedef GAS unsigned gu32;
typedef GAS unsigned long long gu64;
#define RLX_AGENT __ATOMIC_RELAXED, __HIP_MEMORY_SCOPE_AGENT
#define LDS_WAIT() asm volatile("s_waitcnt lgkmcnt(0)" ::: "memory")
#define VM_WAIT() asm volatile("s_waitcnt vmcnt(0)" ::: "memory")
__device__ __forceinline__ unsigned long long rt() { return __builtin_amdgcn_s_memrealtime(); }
__device__ __forceinline__ unsigned f2bf(float f) { unsigned u = __builtin_bit_cast(unsigned, f); return (u + 0x7fffu + ((u >> 16) & 1u)) >> 16; }
__device__ __forceinline__ unsigned pk2(float lo, float hi) { return f2bf(lo) | (f2bf(hi) << 16); }

#define XB_TMO      128
#define XB_XCNT(j)  (256  + 64 * (j))
#define XB_XSUB(j)  (1280 + 64 * (j))
#define XB_XGEN(j)  (2304 + 64 * (j))
#define XB_TOP      3328
#define XB_TOPGEN   3392
#define XCD_BAR_WORDS 3456
#define XB_SPIN_CAP (1u << 18)

__device__ __forceinline__ unsigned xb_ld(unsigned* p)              { return __hip_atomic_load(p, __ATOMIC_RELAXED, __HIP_MEMORY_SCOPE_AGENT); }
__device__ __forceinline__ unsigned xb_add(unsigned* p, unsigned v) { return __hip_atomic_fetch_add(p, v, __ATOMIC_RELAXED, __HIP_MEMORY_SCOPE_AGENT); }
__device__ __forceinline__ unsigned xb_xcc_id() { return (unsigned)__builtin_amdgcn_s_getreg((3 << 11) | 20) & 0xFu; }
#define XB_SPIN(cond, bar) do { unsigned _sp = 0; while (cond) { __builtin_amdgcn_s_sleep(1); \
    if ((++_sp & 255u) == 0u) { if (xb_ld(&(bar)[XB_TMO])) break; if (_sp > XB_SPIN_CAP) { atomicAdd(&(bar)[XB_TMO], 1u); break; } } } } while (0)

struct XcdBarrier {
    unsigned* bar; unsigned x;
    volatile LAS unsigned* st;
};

__device__ __forceinline__ XcdBarrier xcd_barrier_post(unsigned* bar, volatile LAS unsigned* st) {
    XcdBarrier b; b.bar = bar; b.x = xb_xcc_id(); b.st = st;
    if (threadIdx.x == 0) (void)xb_add(&bar[XB_XCNT(b.x)], 1u);
    return b;
}
__device__ __forceinline__ void xcd_barrier_complete(unsigned* bar, unsigned x, unsigned& nloc, unsigned& nx) {
    const unsigned G = gridDim.x * gridDim.y * gridDim.z;
    unsigned sum, cnt, mine, sp = 0u;
    for (;;) {
        sum = 0u; cnt = 0u; mine = 0u;
#pragma unroll
        for (unsigned j = 0; j < 16; ++j) { const unsigned c = xb_ld(&bar[XB_XCNT(j)]); sum += c; cnt += (c > 0u) ? 1u : 0u; mine = (j == x) ? c : mine; }
        if (sum == G) break;
        __builtin_amdgcn_s_sleep(1);
        if ((++sp & 255u) == 0u) { if (xb_ld(&bar[XB_TMO])) break; if (sp > XB_SPIN_CAP) { atomicAdd(&bar[XB_TMO], 1u); break; } }
    }
    nloc = mine > 0u ? mine : 1u; nx = cnt > 0u ? cnt : 1u;
}

__device__ __forceinline__ void xcd_barrier(const XcdBarrier& b) {
    asm volatile("s_waitcnt vmcnt(0)" ::: "memory");
    __syncthreads();
    if (threadIdx.x == 0) {
        unsigned* bar = b.bar;
        __builtin_amdgcn_s_waitcnt(0);
        unsigned nloc = b.st[0], nx = b.st[1];
        if (nloc == 0u) { xcd_barrier_complete(bar, b.x, nloc, nx); b.st[0] = nloc; b.st[1] = nx; }
        const unsigned old = xb_add(&bar[XB_XSUB(b.x)], 1u);
        const unsigned gen = old / nloc;
        if (old + 1u == (gen + 1u) * nloc) {
            __builtin_amdgcn_fence(__ATOMIC_RELEASE, "agent");
            asm volatile("s_waitcnt vmcnt(0)" ::: "memory");
            const unsigned og = xb_add(&bar[XB_TOP], 1u);
            const unsigned tg = og / nx;
            if (og + 1u == (tg + 1u) * nx) xb_add(&bar[XB_TOPGEN], 1u);
            else XB_SPIN(xb_ld(&bar[XB_TOPGEN]) == tg, bar);
            __builtin_amdgcn_fence(__ATOMIC_ACQUIRE, "agent");
            xb_add(&bar[XB_XGEN(b.x)], 1u);
            asm volatile("s_waitcnt vmcnt(0)" ::: "memory");
        } else {
            XB_SPIN(xb_ld(&bar[XB_XGEN(b.x)]) == gen, bar);
            __builtin_amdgcn_fence(__ATOMIC_ACQUIRE, "agent");
            asm volatile("s_waitcnt vmcnt(0)" ::: "memory");
        }
    }
    __syncthreads();
}

constexpr int NWAVES = 8;
constexpr int BATCH = 8, SEQ = 4096, DM = 1024, MTOK = BATCH * SEQ, NMEM = 256, MEMROWS = BATCH * NMEM;
constexpr int NPROJ = 3072;
enum { S_AU = 0, S_AV = 1, S_AG = 2, S_BQ = 3, S_BK = 4, S_BV = 5, S_BG = 6, S_XC = 7, S_XS = 8, S_CG = 9, S_DQ = 10, S_DG = 11 };
constexpr float LOG2E = 1.4426950408889634f;
constexpr float QSCALE = 0.125f * LOG2E;
constexpr int IN_COLS = 2816;

constexpr size_t MiB = 1u << 20;
constexpr size_t WS_CTL = 0, CTL_ZERO_BYTES = 1 * MiB;
constexpr size_t WS_WIN = 2 * MiB;
constexpr size_t WS_WOUT = 14 * MiB;
constexpr size_t WS_WMKV = 18 * MiB;
constexpr size_t WS_WS = 20 * MiB;
constexpr size_t WS_F1 = 20 * MiB + 512 * 1024;
constexpr size_t WS_F2 = WS_F1 + 64 * 1024;
constexpr size_t WS_TW = WS_F2 + 64 * 1024;
constexpr size_t WS_MEMA = 22 * MiB;
constexpr size_t WS_MKV = 26 * MiB;
constexpr size_t WS_PART = 30 * MiB;
constexpr size_t WS_XB = 32 * MiB;
constexpr size_t WS_P = 96 * MiB;
constexpr size_t WS_Y = 288 * MiB;
constexpr size_t WS_T = 352 * MiB;
constexpr size_t WS_END = 384 * MiB;
constexpr int CW_BAR = 4096;

constexpr int RING_BYTES = 131072;
constexpr int ATT_K_OFF = 0, ATT_IMG_BYTES = 9 * 64 * 128, ATT_V_OFF = ATT_IMG_BYTES, ATT_BT_OFF = 2 * ATT_IMG_BYTES;
constexpr int LDSCTL_OFF = 155 * 1024, MISC_OFF = LDSCTL_OFF + 320;
constexpr int LDS_BYTES = 156 * 1024;
static_assert(ATT_BT_OFF + 15 * 32 * 4 <= LDSCTL_OFF && MISC_OFF + 128 <= LDS_BYTES, "LDS map");

typedef short s16x4 __attribute__((ext_vector_type(4)));
typedef unsigned u32x2v __attribute__((ext_vector_type(2)));

struct Frame {
    LAS unsigned char* lds;
    volatile LAS unsigned* MISC;
    gu32* ctl;
    int tid, lane, wave, vcu, G;
    const float* in[17];
    float* out; unsigned char* ws;
};
enum { I_X = 0, I_MEM, I_NORMG, I_WIN, I_WOUT, I_LNG, I_LNB, I_WS, I_BS, I_NAQ, I_NAK, I_RPB, I_FNW, I_MEMNG, I_WMKV, I_MQ, I_MK };

__device__ __forceinline__ float bf_lo(unsigned w) { return __uint_as_float(w << 16); }
__device__ __forceinline__ float bf_hi(unsigned w) { return __uint_as_float(w & 0xffff0000u); }
__device__ __forceinline__ unsigned pkbf(float lo, float hi) { return pg8::cvt_pk_bf16(lo, hi); }
__device__ __forceinline__ float silu_f(float x) { return x / (1.0f + __expf(-x)); }
__device__ __forceinline__ float wave_sum(float v) {
#pragma unroll
    for (int o = 1; o < 64; o <<= 1) v += __shfl_xor(v, o);
    return v;
}
__device__ __forceinline__ s16x4 tr_read(LAS const unsigned char* p) {
    typedef short v4i16_t __attribute__((ext_vector_type(4)));
    return __builtin_bit_cast(s16x4, __builtin_amdgcn_ds_read_tr16_b64_v4i16((LAS v4i16_t*)p));
}

__device__ __forceinline__ void tr_store(LAS const float* scr, bf16* dst, int K, int lane) {
    const int c = lane & 7;
#pragma unroll
    for (int j = 0; j < 4; ++j) { const int n = (lane >> 3) + 8 * j; const LAS float* s = scr + (8 * c) * 33 + n;
        v4u o; o.x = pkbf(s[0 * 33], s[1 * 33]); o.y = pkbf(s[2 * 33], s[3 * 33]); o.z = pkbf(s[4 * 33], s[5 * 33]); o.w = pkbf(s[6 * 33], s[7 * 33]);
        *(GAS v4u*)(dst + (size_t)n * K + 8 * c) = o; }
}
__device__ __forceinline__ void tr_item_plain(const float* src, int ld, const float* gk, bf16* dst, int K, LAS float* scr, int lane) {
#pragma unroll 8
    for (int i = 0; i < 32; ++i) { const int kk = 2 * i + (lane >> 5); float v = src[(size_t)kk * ld + (lane & 31)]; if (gk) v *= gk[kk]; scr[kk * 33 + (lane & 31)] = v; }
    LDS_WAIT(); asm volatile("" ::: "memory");
    tr_store(scr, dst, K, lane);
    LDS_WAIT(); asm volatile("" ::: "memory");
}
__device__ __forceinline__ void tr_item_fold(const float* winrow  , const float* gk, const float* wf  , LAS const float* tab  ,
                                             bf16* dst, LAS float* scr, LAS float* scr2, int lane) {
    const int e = lane & 31, hh = lane >> 5;
    {   float wcol[64];
#pragma unroll
        for (int dp = 0; dp < 64; ++dp) wcol[dp] = wf[dp * 64 + e];
        for (int di = 0; di < 32; ++di) { const int d = 32 * hh + di; float s = 0.f;
#pragma unroll
            for (int dp = 0; dp < 64; ++dp) s += tab[(d * dp) & 63] * wcol[dp];
            scr2[d * 33 + e] = s * 0.125f; }
    }
    LDS_WAIT(); asm volatile("" ::: "memory");
    for (int ki = 0; ki < 32; ++ki) { const int kk = 32 * hh + ki; const GAS f32x4* wr = (const GAS f32x4*)(winrow + (size_t)kk * IN_COLS); float s = 0.f;
#pragma unroll
        for (int d4 = 0; d4 < 16; ++d4) { const f32x4 w = wr[d4];
            s += w[0] * scr2[(4 * d4 + 0) * 33 + e]; s += w[1] * scr2[(4 * d4 + 1) * 33 + e]; s += w[2] * scr2[(4 * d4 + 2) * 33 + e]; s += w[3] * scr2[(4 * d4 + 3) * 33 + e]; }
        scr[kk * 33 + e] = s * gk[kk]; }
    LDS_WAIT(); asm volatile("" ::: "memory");
    tr_store(scr, dst, 1024, lane);
    LDS_WAIT(); asm volatile("" ::: "memory");
}
__device__ __forceinline__ int src_col_of_slot(int t) { return t <= 6 ? 256 * t : (t == 9 ? 2048 : (t == 10 ? 2304 : 2560)); }

#define FRESH_LANES(F) do { int t_ = threadIdx.x; asm volatile("" : "+v"(t_)); (F).tid = t_; (F).lane = t_ & 63; } while (0)
__device__ __forceinline__ void p0_prologue(Frame& F) {
    FRESH_LANES(F);
    LAS float* tabc = (LAS float*)(F.lds + 8 * 16896);
    LAS float* tabs = tabc + 64;
    if (F.tid < 64) { float s, c; sincospif((float)F.tid * (1.0f / 32.0f), &s, &c); tabc[F.tid] = c; tabs[F.tid] = s; }
    __syncthreads();
    LAS float* scr = (LAS float*)(F.lds + F.wave * 16896);
    LAS float* scr2 = scr + 64 * 33;
    const int gw = F.vcu * NWAVES + F.wave, NGW = F.G * NWAVES;
    bf16* WinT = (bf16*)(F.ws + WS_WIN); bf16* WoutT = (bf16*)(F.ws + WS_WOUT); bf16* WmkvT = (bf16*)(F.ws + WS_WMKV);
    constexpr int N_IN = 2 * 16 * 96, N_OUT = 2 * 16 * 32, N_KV = 2 * 16 * 16, NIT = N_IN + N_OUT + N_KV;
    for (int it = gw; it < NIT; it += NGW) {
        int r = it;
        if (r < N_IN) { const int l = r / 1536; r -= l * 1536; const int kb = r / 96, nb = r % 96, pn = nb >> 3, bj = (nb >> 2) & 1, wc = nb & 3, k0 = 64 * kb;
            bf16* dst = WinT + ((size_t)l * NPROJ + 32 * nb) * 1024 + k0; const float* gk = F.in[I_NORMG] + l * 1024 + k0;
            const float* win = F.in[I_WIN] + (size_t)l * 1024 * IN_COLS + (size_t)k0 * IN_COLS;
            if (pn == S_XC || pn == S_XS) tr_item_fold(win + 1792 + 64 * wc, gk, F.in[I_FNW] + (size_t)((l * 4 + wc) * 64) * 64 + 32 * bj, pn == S_XC ? tabc : tabs, dst, scr, scr2, F.lane);
            else tr_item_plain(win + src_col_of_slot(pn) + 64 * wc + 32 * bj, IN_COLS, gk, dst, 1024, scr, F.lane);
            continue; }
        r -= N_IN;
        if (r < N_OUT) { const int l = r / 512; r -= l * 512; const int kb = r / 32, nb = r % 32, k0 = 64 * kb;
            tr_item_plain(F.in[I_WOUT] + (size_t)l * 1024 * 1024 + (size_t)k0 * 1024 + 32 * nb, 1024, nullptr, WoutT + ((size_t)l * 1024 + 32 * nb) * 1024 + k0, 1024, scr, F.lane);
            continue; }
        r -= N_OUT;
        { const int l = r / 256; r -= l * 256; const int kb = r / 16, nb = r % 16, kv = nb >> 3, bj = (nb >> 2) & 1, wc = nb & 3, k0 = 64 * kb;
            tr_item_plain(F.in[I_WMKV] + (size_t)l * 1024 * 512 + (size_t)k0 * 512 + 256 * kv + 64 * wc + 32 * bj, 512, F.in[I_MEMNG] + l * 1024 + k0,
                          WmkvT + ((size_t)l * 512 + 32 * nb) * 1024 + k0, 1024, scr, F.lane); }
    }
    { bf16* WsB = (bf16*)(F.ws + WS_WS); const float* ws_in = F.in[I_WS];
      for (int i = gw * 64 + F.lane; i < 2 * 4 * 128 * 128 / 2; i += NGW * 64) ((GAS unsigned*)WsB)[i] = pkbf(ws_in[2 * i], ws_in[2 * i + 1]);
      bf16* F1 = (bf16*)(F.ws + WS_F1);
      for (int i = gw * 64 + F.lane; i < 128 * 128; i += NGW * 64) { const int m = i >> 7, kk = i & 127, part = m >> 6, k1 = m & 63, src = kk >> 6, s1 = kk & 63;
          float s, c; sincospif((float)((k1 * s1) & 63) * (1.0f / 32.0f), &s, &c);
          const float v = (part == 0) ? (src == 0 ? c : -s) : (src == 0 ? -s : -c);
          F1[i] = (bf16)(pkbf(v * 0.125f, 0.f) & 0xffffu); }
      bf16* F2 = (bf16*)(F.ws + WS_F2);
      for (int i = gw * 64 + F.lane; i < 64 * 128; i += NGW * 64) { const int k2 = i >> 7, kk = i & 127, src = kk >> 6, s2 = kk & 63;
          float s, c; sincospif((float)((k2 * s2) & 63) * (1.0f / 32.0f), &s, &c);
          F2[i] = (bf16)(pkbf((src == 0 ? c : s) * 0.125f, 0.f) & 0xffffu); }
      float* TW = (float*)(F.ws + WS_TW);
      for (int i = gw * 64 + F.lane; i < 64 * 64; i += NGW * 64) { const int s2 = i >> 6, k1 = i & 63; float s, c; sincospif((float)(s2 * k1) * (1.0f / 2048.0f), &s, &c); TW[2 * i] = c; TW[2 * i + 1] = s; }
    }
    { bf16* memA = (bf16*)(F.ws + WS_MEMA);
      for (int m = gw; m < MEMROWS; m += NGW) { const GAS f32x4* xr = (const GAS f32x4*)(F.in[I_MEM] + (size_t)m * DM) + F.lane; f32x4 v[4]; float s = 0.f;
#pragma unroll
          for (int j = 0; j < 4; ++j) { v[j] = xr[64 * j]; s += (v[j][0] * v[j][0] + v[j][1] * v[j][1]) + (v[j][2] * v[j][2] + v[j][3] * v[j][3]); }
          const float rstd = 1.0f / sqrtf(wave_sum(s) * (1.0f / DM) + 1e-6f);
          GAS u32x2v* o8 = (GAS u32x2v*)(memA + (size_t)m * DM) + F.lane;
#pragma unroll
          for (int j = 0; j < 4; ++j) { u32x2v w; w.x = pkbf(v[j][0] * rstd, v[j][1] * rstd); w.y = pkbf(v[j][2] * rstd, v[j][3] * rstd); o8[64 * j] = w; } }
    }
    { bf16* XB = (bf16*)(F.ws + WS_XB); float* part = (float*)(F.ws + WS_PART);
      for (int m = gw; m < MTOK; m += NGW) { const GAS f32x4* xr = (const GAS f32x4*)(F.in[I_X] + (size_t)m * DM) + F.lane; f32x4 v[4]; float s = 0.f;
#pragma unroll
          for (int j = 0; j < 4; ++j) { v[j] = xr[64 * j]; s += (v[j][0] * v[j][0] + v[j][1] * v[j][1]) + (v[j][2] * v[j][2] + v[j][3] * v[j][3]); }
          s = wave_sum(s);
          GAS u32x2v* o8 = (GAS u32x2v*)(XB + (size_t)m * DM) + F.lane;
#pragma unroll
          for (int j = 0; j < 4; ++j) { u32x2v w; w.x = pkbf(v[j][0], v[j][1]); w.y = pkbf(v[j][2], v[j][3]); o8[64 * j] = w; }
          if (F.lane < 4) *(GAS f32x4*)(part + (size_t)m * 16 + 4 * F.lane) = (f32x4){F.lane == 0 ? s : 0.f, 0.f, 0.f, 0.f}; }
    }
}

__device__ __forceinline__ int img_swz(int row) { return ((row & 3) << 5) | (((row >> 3) & 1) << 7); }
template <int NT>
__device__ __forceinline__ void spatial_core(LAS const unsigned char* img, const bf16* Amat, const int (&arow)[NT], int chbase, int lane, f32x4 (&acc)[4][NT]) {
    const int g = lane >> 4, r = lane & 15, q = r >> 2, p = r & 3;
    const int sw = (q << 5) | ((g & 1) << 7);
#pragma unroll
    for (int mt = 0; mt < 4; ++mt)
#pragma unroll
        for (int nt = 0; nt < NT; ++nt) acc[mt][nt] = (f32x4){0.f, 0.f, 0.f, 0.f};
#pragma unroll
    for (int ks = 0; ks < 4; ++ks) {
        bf16x8 bw[NT];
#pragma unroll
        for (int nt = 0; nt < NT; ++nt) bw[nt] = *(const GAS bf16x8*)(Amat + (size_t)(arow[nt] + r) * 128 + ks * 32 + g * 8);
        const int row0 = ks * 32 + g * 8 + q;
#pragma unroll
        for (int mt = 0; mt < 4; ++mt) {
            const int cb = ((2 * chbase + 32 * mt) ^ sw) + 8 * p;
            const s16x4 lo = tr_read(img + row0 * 512 + cb), hi = tr_read(img + (row0 + 4) * 512 + cb);
            const bf16x8 av = (bf16x8){lo[0], lo[1], lo[2], lo[3], hi[0], hi[1], hi[2], hi[3]};
#pragma unroll
            for (int nt = 0; nt < NT; ++nt) acc[mt][nt] = __builtin_amdgcn_mfma_f32_16x16x32_bf16(av, bw[nt], acc[mt][nt], 0, 0, 0);
        }
    }
}
#define IMG_FILL(ROWPTR_EXPR) do { \
    _Pragma("unroll") for (int it_ = 0; it_ < 8; ++it_) { const int id_ = F.tid + 512 * it_, kk = id_ >> 5, c_ = id_ & 31; \
        const v4u val_ = *(const GAS v4u*)((ROWPTR_EXPR) + 8 * c_); \
        *(LAS v4u*)(F.lds + kk * 512 + ((16 * c_) ^ img_swz(kk))) = val_; } } while (0)

__device__ __forceinline__ void store4bf(bf16* p, float a, float b, float c, float d) { u32x2v w; w.x = pkbf(a, b); w.y = pkbf(c, d); *(GAS u32x2v*)p = w; }
__device__ __forceinline__ void load4bf(const bf16* p, float (&o)[4]) { const u32x2v w = *(const GAS u32x2v*)p; o[0] = bf_lo(w.x); o[1] = bf_hi(w.x); o[2] = bf_lo(w.y); o[3] = bf_hi(w.y); }

__device__ __forceinline__ void gmlp_unit(Frame& F, int l, int b, int chunk) {
    FRESH_LANES(F);
    const bf16* P = (const bf16*)(F.ws + WS_P); bf16* Y = (bf16*)(F.ws + WS_Y);
    const int tok0 = b * SEQ + 128 * chunk, w = F.wave, lane = F.lane;
    {
        const int l32 = lane & 31, half = lane >> 5, c0 = 8 * l32;
        float lg[8], lb[8];
#pragma unroll
        for (int j = 0; j < 8; ++j) { lg[j] = F.in[I_LNG][l * 256 + c0 + j]; lb[j] = F.in[I_LNB][l * 256 + c0 + j]; }
#pragma unroll 2
        for (int it = 0; it < 8; ++it) { const int tl = 16 * w + 2 * it + half;
            const v4u raw = *(const GAS v4u*)(P + (size_t)(tok0 + tl) * NPROJ + S_AV * 256 + c0);
            float x[8] = {bf_lo(raw.x), bf_hi(raw.x), bf_lo(raw.y), bf_hi(raw.y), bf_lo(raw.z), bf_hi(raw.z), bf_lo(raw.w), bf_hi(raw.w)};
            float s = ((x[0] + x[1]) + (x[2] + x[3])) + ((x[4] + x[5]) + (x[6] + x[7]));
#pragma unroll
            for (int o = 1; o < 32; o <<= 1) s += __shfl_xor(s, o);
            const float mean = s * (1.0f / 256.0f); float v = 0.f;
#pragma unroll
            for (int j = 0; j < 8; ++j) { x[j] -= mean; v += x[j] * x[j]; }
#pragma unroll
            for (int o = 1; o < 32; o <<= 1) v += __shfl_xor(v, o);
            const float rstd = 1.0f / sqrtf(v * (1.0f / 256.0f) + 1e-6f);
#pragma unroll
            for (int j = 0; j < 8; ++j) x[j] = x[j] * rstd * lg[j] + lb[j];
            v4u o; o.x = pkbf(x[0], x[1]); o.y = pkbf(x[2], x[3]); o.z = pkbf(x[4], x[5]); o.w = pkbf(x[6], x[7]);
            *(LAS v4u*)(F.lds + tl * 512 + ((2 * c0) ^ img_swz(tl))) = o; }
    }
    __syncthreads();
    const int h = w >> 1, ph = w & 1, g = lane >> 4, r = lane & 15;
    const int arow[4] = {h * 128 + 64 * ph, h * 128 + 64 * ph + 16, h * 128 + 64 * ph + 32, h * 128 + 64 * ph + 48};
    f32x4 acc[4][4];
    spatial_core<4>(F.lds, (const bf16*)(F.ws + WS_WS) + (size_t)l * 4 * 128 * 128, arow, 64 * h, lane, acc);
#pragma unroll
    for (int nt = 0; nt < 4; ++nt) { const int p = 64 * ph + 16 * nt + r; const size_t tok = (size_t)(tok0 + p); const float bs = F.in[I_BS][(l * 4 + h) * 128 + p];
#pragma unroll
        for (int mt = 0; mt < 4; ++mt) { const int ch = 64 * h + 16 * mt + 4 * g; float u[4], gt[4];
            load4bf(P + tok * NPROJ + S_AU * 256 + ch, u); load4bf(P + tok * NPROJ + S_AG * 256 + ch, gt);
            store4bf(Y + tok * DM + ch, u[0] * (acc[mt][nt][0] + bs) * silu_f(gt[0]), u[1] * (acc[mt][nt][1] + bs) * silu_f(gt[1]),
                     u[2] * (acc[mt][nt][2] + bs) * silu_f(gt[2]), u[3] * (acc[mt][nt][3] + bs) * silu_f(gt[3])); } }
    __syncthreads();
}
__device__ __forceinline__ void fft1_unit(Frame& F, int b, int s2) {
    FRESH_LANES(F);
    const bf16* P = (const bf16*)(F.ws + WS_P); bf16* T = (bf16*)(F.ws + WS_T);
    const int w = F.wave, lane = F.lane;
    IMG_FILL(P + (size_t)(b * SEQ + 64 * (kk & 63) + s2) * NPROJ + (kk < 64 ? S_XC : S_XS) * 256);
    __syncthreads();
    const int cs = w >> 1, kh = w & 1, g = lane >> 4, r = lane & 15;
    const int arow[4] = {32 * kh, 32 * kh + 16, 64 + 32 * kh, 64 + 32 * kh + 16};
    f32x4 acc[4][4];
    spatial_core<4>(F.lds, (const bf16*)(F.ws + WS_F1), arow, 64 * cs, lane, acc);
    const float* TW = (const float*)(F.ws + WS_TW);
#pragma unroll
    for (int a = 0; a < 2; ++a) { const int k1 = 32 * kh + 16 * a + r; const float ct = TW[2 * (s2 * 64 + k1)], st = TW[2 * (s2 * 64 + k1) + 1];
        bf16* tr_ = T + ((size_t)((b * 64 + k1) * 2 + 0) * 64 + s2) * 256; bf16* ti_ = tr_ + (size_t)64 * 256;
#pragma unroll
        for (int mt = 0; mt < 4; ++mt) { const int ch = 64 * cs + 16 * mt + 4 * g; const f32x4 Ar = acc[mt][a], Ai = acc[mt][a + 2];
            store4bf(tr_ + ch, Ar[0] * ct + Ai[0] * st, Ar[1] * ct + Ai[1] * st, Ar[2] * ct + Ai[2] * st, Ar[3] * ct + Ai[3] * st);
            store4bf(ti_ + ch, Ai[0] * ct - Ar[0] * st, Ai[1] * ct - Ar[1] * st, Ai[2] * ct - Ar[2] * st, Ai[3] * ct - Ar[3] * st); } }
    __syncthreads();
}
__device__ __forceinline__ void fft2_unit(Frame& F, int b, int k1) {
    FRESH_LANES(F);
    const bf16* P = (const bf16*)(F.ws + WS_P); const bf16* T = (const bf16*)(F.ws + WS_T); bf16* Y = (bf16*)(F.ws + WS_Y);
    const int w = F.wave, lane = F.lane;
    IMG_FILL(T + ((size_t)(b * 64 + k1) * 128 + kk) * 256);
    __syncthreads();
    const int cs = w >> 1, k2h = w & 1, g = lane >> 4, r = lane & 15;
    const int arow[2] = {32 * k2h, 32 * k2h + 16};
    f32x4 acc[4][2];
    spatial_core<2>(F.lds, (const bf16*)(F.ws + WS_F2), arow, 64 * cs, lane, acc);
#pragma unroll
    for (int nt = 0; nt < 2; ++nt) { const int k2 = 32 * k2h + 16 * nt + r; const size_t tok = (size_t)(b * SEQ + 64 * k2 + k1);
#pragma unroll
        for (int mt = 0; mt < 4; ++mt) { const int ch = 64 * cs + 16 * mt + 4 * g; float gt[4]; load4bf(P + tok * NPROJ + S_CG * 256 + ch, gt);
            store4bf(Y + tok * DM + 512 + ch, acc[mt][nt][0] * silu_f(gt[0]), acc[mt][nt][1] * silu_f(gt[1]), acc[mt][nt][2] * silu_f(gt[2]), acc[mt][nt][3] * silu_f(gt[3])); } }
    __syncthreads();
}

__device__ __forceinline__ int att_f(int row) { return ((row >> 1) & 1) | (((row >> 3) & 1) << 1); }
#define ATT_CORE(KIMG, VIMG, ROWBASE, FIX, QF, O, LSUM) do { \
    const int g_ = lane >> 4, r_ = lane & 15, q_ = r_ >> 2, p_ = r_ & 3; \
    f32x4 s_[16]; \
    _Pragma("unroll") for (int kk = 0; kk < 8; ++kk) { const int rb_ = (ROWBASE); \
        _Pragma("unroll") for (int hh = 0; hh < 2; ++hh) { const int R_ = rb_ + 8 * (r_ >> 2) + 4 * hh + (r_ & 3); const int f_ = att_f(R_) << 5; \
            const bf16x8 k0_ = *(const LAS bf16x8*)((KIMG) + R_ * 128 + ((16 * g_) ^ f_)); \
            const bf16x8 k1_ = *(const LAS bf16x8*)((KIMG) + R_ * 128 + ((64 + 16 * g_) ^ f_)); \
            f32x4 a_ = __builtin_amdgcn_mfma_f32_16x16x32_bf16(k0_, (QF)[0], (f32x4){0.f, 0.f, 0.f, 0.f}, 0, 0, 0); \
            a_ = __builtin_amdgcn_mfma_f32_16x16x32_bf16(k1_, (QF)[1], a_, 0, 0, 0); \
            _Pragma("unroll") for (int i = 0; i < 4; ++i) { float sv_ = a_[i]; FIX; a_[i] = sv_; } \
            s_[2 * kk + hh] = a_; } } \
    float mx_ = -1e30f; \
    _Pragma("unroll") for (int t = 0; t < 16; ++t) mx_ = fmaxf(fmaxf(mx_, fmaxf(s_[t][0], s_[t][1])), fmaxf(s_[t][2], s_[t][3])); \
    mx_ = fmaxf(mx_, __shfl_xor(mx_, 16)); mx_ = fmaxf(mx_, __shfl_xor(mx_, 32)); \
    float sum_ = 0.f; \
    _Pragma("unroll") for (int t = 0; t < 16; ++t) { _Pragma("unroll") for (int i = 0; i < 4; ++i) { const float e_ = __builtin_amdgcn_exp2f(s_[t][i] - mx_); s_[t][i] = e_; sum_ += e_; } } \
    sum_ += __shfl_xor(sum_, 16); sum_ += __shfl_xor(sum_, 32); (LSUM) = sum_; \
    _Pragma("unroll") for (int dt = 0; dt < 4; ++dt) (O)[dt] = (f32x4){0.f, 0.f, 0.f, 0.f}; \
    _Pragma("unroll") for (int kk = 0; kk < 8; ++kk) { const int rb_ = (ROWBASE); \
        v4u pw_; pw_.x = pkbf(s_[2 * kk][0], s_[2 * kk][1]); pw_.y = pkbf(s_[2 * kk][2], s_[2 * kk][3]); pw_.z = pkbf(s_[2 * kk + 1][0], s_[2 * kk + 1][1]); pw_.w = pkbf(s_[2 * kk + 1][2], s_[2 * kk + 1][3]); \
        const bf16x8 pf_ = __builtin_bit_cast(bf16x8, pw_); \
        const int R0_ = rb_ + 8 * g_ + q_, R1_ = R0_ + 4; const int f0_ = att_f(R0_), f1_ = att_f(R1_); \
        _Pragma("unroll") for (int dt = 0; dt < 4; ++dt) { \
            const s16x4 lo_ = tr_read((VIMG) + R0_ * 128 + 32 * (dt ^ f0_) + 8 * p_), hi_ = tr_read((VIMG) + R1_ * 128 + 32 * (dt ^ f1_) + 8 * p_); \
            const bf16x8 vf_ = (bf16x8){lo_[0], lo_[1], lo_[2], lo_[3], hi_[0], hi_[1], hi_[2], hi_[3]}; \
            (O)[dt] = __builtin_amdgcn_mfma_f32_16x16x32_bf16(vf_, pf_, (O)[dt], 0, 0, 0); } } \
    } while (0)

__device__ __forceinline__ void att_epilogue(const f32x4 (&o)[4], float lsum, const bf16* gate_row, bf16* y_row, int g) {
    const float inv = 1.0f / lsum;
#pragma unroll
    for (int dt = 0; dt < 4; ++dt) { float gt[4]; load4bf(gate_row + 16 * dt + 4 * g, gt);
        store4bf(y_row + 16 * dt + 4 * g, o[dt][0] * inv * silu_f(gt[0]), o[dt][1] * inv * silu_f(gt[1]), o[dt][2] * inv * silu_f(gt[2]), o[dt][3] * inv * silu_f(gt[3])); }
}

__device__ __forceinline__ void natten_unit(Frame& F, int l, int b, int h, int rp) {
    FRESH_LANES(F);
    const bf16* P = (const bf16*)(F.ws + WS_P); bf16* Y = (bf16*)(F.ws + WS_Y);
    const int w = F.wave, lane = F.lane, tid = F.tid;
    const int r0 = 2 * rp; int rsA = r0 - 4; rsA = rsA < 0 ? 0 : (rsA > 56 ? 56 : rsA); const int base = rsA < 55 ? rsA : 55;
    LAS unsigned char* Kimg = F.lds + ATT_K_OFF; LAS unsigned char* Vimg = F.lds + ATT_V_OFF; LAS float* bt = (LAS float*)(F.lds + ATT_BT_OFF);
    const bf16* Pb = P + (size_t)(b * SEQ + base * 64) * NPROJ + 64 * h;
#pragma unroll
    for (int it3 = 0; it3 < 3; ++it3) { v4u kv[3], vv[3];
#pragma unroll
        for (int j = 0; j < 3; ++j) { const int id = tid + 512 * (3 * it3 + j), key = id >> 3, c = id & 7; const bf16* src = Pb + (size_t)key * NPROJ + 8 * c;
            kv[j] = *(const GAS v4u*)(src + S_BK * 256); vv[j] = *(const GAS v4u*)(src + S_BV * 256); }
#pragma unroll
        for (int j = 0; j < 3; ++j) { const int id = tid + 512 * (3 * it3 + j), key = id >> 3, c = id & 7; const int off = key * 128 + ((16 * c) ^ (att_f(key) << 5));
            *(LAS v4u*)(Kimg + off) = kv[j]; *(LAS v4u*)(Vimg + off) = vv[j]; } }
    if (tid < 15 * 32) { const int dr = tid >> 5, dc = tid & 31; bt[tid] = dc < 31 ? F.in[I_RPB][((l * 4 + h) * 15 + dr) * 31 + dc] * LOG2E : 0.f; }
    const int qrow = r0 + (w >> 2), qg = w & 3, g = lane >> 4, r = lane & 15;
    const size_t tok = (size_t)(b * SEQ + qrow * 64 + 16 * qg + r);
    bf16x8 qf[2];
    qf[0] = *(const GAS bf16x8*)(P + tok * NPROJ + S_BQ * 256 + 64 * h + 8 * g); qf[1] = *(const GAS bf16x8*)(P + tok * NPROJ + S_BQ * 256 + 64 * h + 32 + 8 * g);
    __syncthreads();
    int rs = qrow - 4; rs = rs < 0 ? 0 : (rs > 56 ? 56 : rs);
    const int lr0 = rs - base, cb = (qg == 0) ? 0 : (qg == 1 ? 8 : (qg == 2 ? 24 : 32)), dr0 = rs - qrow + 7;
    const int cq = 16 * qg + r; int cs = cq - 8; cs = cs < 0 ? 0 : (cs > 48 ? 48 : cs);
    const int ck0 = cb + 8 * g - cs;
    const int dc0 = cb + 8 * g - cq + 15;
    f32x4 o[4]; float lsum;
#define NA_FIX { const int rel_ = ck0 + 4 * hh + i; int dc_ = dc0 + 4 * hh + i; dc_ = dc_ < 0 ? 0 : (dc_ > 30 ? 30 : dc_); \
        const float bias_ = bt[(dr0 + kk) * 32 + dc_]; sv_ = ((unsigned)rel_ < 16u) ? sv_ + bias_ : -1e30f; }
    ATT_CORE(Kimg, Vimg, ((lr0 + kk) * 64 + cb), NA_FIX, qf, o, lsum);
#undef NA_FIX
    att_epilogue(o, lsum, P + tok * NPROJ + S_BG * 256 + 64 * h, Y + tok * DM + 256 + 64 * h, g);
    __syncthreads();
}
__device__ __forceinline__ void memattn_unit(Frame& F, int l, int b, int h, int tb) {
    FRESH_LANES(F);
    const bf16* P = (const bf16*)(F.ws + WS_P); bf16* Y = (bf16*)(F.ws + WS_Y); const bf16* MKV = (const bf16*)(F.ws + WS_MKV);
    const int w = F.wave, lane = F.lane, tid = F.tid;
    LAS unsigned char* Kimg = F.lds + ATT_K_OFF; LAS unsigned char* Vimg = F.lds + ATT_V_OFF;
    const bf16* Mb = MKV + (size_t)(b * NMEM) * 1024 + l * 512 + 64 * h;
    { v4u kv[4], vv[4];
#pragma unroll
      for (int j = 0; j < 4; ++j) { const int id = tid + 512 * j, key = id >> 3, c = id & 7; const bf16* src = Mb + (size_t)key * 1024 + 8 * c; kv[j] = *(const GAS v4u*)src; vv[j] = *(const GAS v4u*)(src + 256); }
#pragma unroll
      for (int j = 0; j < 4; ++j) { const int id = tid + 512 * j, key = id >> 3, c = id & 7; const int off = key * 128 + ((16 * c) ^ (att_f(key) << 5));
          *(LAS v4u*)(Kimg + off) = kv[j]; *(LAS v4u*)(Vimg + off) = vv[j]; } }
    __syncthreads();
    const int g = lane >> 4, r = lane & 15;
    for (int rnd = 0; rnd < 4; ++rnd) {
        const size_t tok = (size_t)(b * SEQ + 512 * tb + 128 * rnd + 16 * w + r);
        bf16x8 qf[2];
        qf[0] = *(const GAS bf16x8*)(P + tok * NPROJ + S_DQ * 256 + 64 * h + 8 * g); qf[1] = *(const GAS bf16x8*)(P + tok * NPROJ + S_DQ * 256 + 64 * h + 32 + 8 * g);
        f32x4 o[4]; float lsum;
        ATT_CORE(Kimg, Vimg, (32 * kk), {}, qf, o, lsum);
        att_epilogue(o, lsum, P + tok * NPROJ + S_DG * 256 + 64 * h, Y + tok * DM + 768 + 64 * h, g);
    }
    __syncthreads();
}

constexpr int N_PHASES = 9;
struct Args { const float* in[17]; float* out; unsigned char* ws; int ph_lo, ph_hi; };
__global__ void __launch_bounds__(NWAVES * 64, 2) mk_fwd(Args args) {
    extern __shared__ __attribute__((aligned(16))) unsigned char lds[];
    Frame F;
    F.lds = (LAS unsigned char*)lds;
    F.MISC = (volatile LAS unsigned*)(F.lds + MISC_OFF);
    F.tid = threadIdx.x; F.lane = F.tid & 63; F.wave = __builtin_amdgcn_readfirstlane(F.tid >> 6);
    F.G = gridDim.x; { const int bx = blockIdx.x; F.vcu = (F.G % 8 == 0) ? (bx % 8) * (F.G / 8) + bx / 8 : bx; }
    F.ws = args.ws; F.out = args.out; F.ctl = (gu32*)(args.ws + WS_CTL);
#pragma unroll
    for (int i = 0; i < 17; ++i) F.in[i] = args.in[i];
    for (int u = F.tid; u < (LDS_BYTES - LDSCTL_OFF) / 4; u += NWAVES * 64) ((LAS unsigned*)(F.lds + LDSCTL_OFF))[u] = 0u;
    __syncthreads();
    const int lo = args.ph_lo, hi = args.ph_hi;
    const bool one_launch = (hi - lo) > 1;
    XcdBarrier bar; bar.bar = (unsigned*)(F.ctl + CW_BAR); bar.x = 0; bar.st = nullptr;
    if (one_launch) bar = xcd_barrier_post((unsigned*)(F.ctl + CW_BAR), F.MISC + 8);

    bf16* WinT = (bf16*)(F.ws + WS_WIN); bf16* WoutT = (bf16*)(F.ws + WS_WOUT); bf16* WmkvT = (bf16*)(F.ws + WS_WMKV);
    bf16* XB = (bf16*)(F.ws + WS_XB); bf16* PB = (bf16*)(F.ws + WS_P); bf16* YB = (bf16*)(F.ws + WS_Y); float* PART = (float*)(F.ws + WS_PART);

    for (int ph = lo; ph < hi; ++ph) {
        if (ph == 0) {
#ifndef NO_PRO
 p0_prologue(F);
#endif
 __syncthreads(); }
        else {
            const int l = (ph - 1) >> 2, k = (ph - 1) & 3;
            if (k == 0) {
                const int j0 = (l == 0) ? 0 : 1;
                for (int j = j0; j < 2; ++j) {
                    pg8::Gemm g; pg8::EpiProj E; pg8::StaticOrder S;
                    if (j == 0) {
                        g = pg8::Gemm{(const pg8::bf16_t*)(F.ws + WS_MEMA), WmkvT, MEMROWS, 1024, 1024};
                        E = pg8::EpiProj{(pg8::bf16_t*)(F.ws + WS_MKV), 1024, nullptr, F.in[I_MK], F.in[I_MK] + 64, nullptr, 0, 2, -1, 1.f, 1.f, 1.f};
                        S.init(MEMROWS, 1024, F.G, (int)blockIdx.x);
                    } else {
                        g = pg8::Gemm{XB, WinT + (size_t)l * NPROJ * 1024, MTOK, NPROJ, 1024};
                        E = pg8::EpiProj{PB, NPROJ, PART, F.in[I_NAQ] + 64 * l, F.in[I_NAK] + 64 * l, F.in[I_MQ] + 64 * l, S_BQ, S_BK, S_DQ, QSCALE, 1.f, QSCALE};
                        S.init(MTOK, NPROJ, F.G, (int)blockIdx.x);
                    }
#ifndef NO_G1
                    pg8::gemm_phase<pg8::EpiProj, pg8::StaticOrder, true, true>(F.lds, g, S, E);
#endif
                }
            } else if (k == 1) {
#ifndef NO_GMLP
                for (int u = F.vcu; u < 256; u += F.G) gmlp_unit(F, l, u >> 5, u & 31);
#endif
#ifndef NO_FFT1
                for (int u = F.vcu; u < 256; u += F.G) for (int j = 0; j < 2; ++j) fft1_unit(F, u >> 5, 2 * (u & 31) + j);
#endif
#ifndef NO_NAT
                for (int u = F.vcu; u < 256; u += F.G) for (int j = 0; j < 4; ++j) natten_unit(F, l, u >> 5, (u & 31) >> 3, 4 * (u & 7) + j);
#endif
#ifndef NO_MEMA
                for (int u = F.vcu; u < 256; u += F.G) memattn_unit(F, l, u >> 5, (u & 31) >> 3, u & 7);
#endif
            } else if (k == 2) {
#ifndef NO_FFT2
                for (int u = F.vcu; u < 256; u += F.G) for (int j = 0; j < 2; ++j) fft2_unit(F, u >> 5, 2 * (u & 31) + j);
#endif
            } else {
                pg8::Gemm g{YB, WoutT + (size_t)l * 1024 * 1024, MTOK, DM, 1024};
                pg8::EpiOut E{l == 0 ? F.in[I_X] : (const float*)F.out, F.out, l == 0 ? XB : nullptr, PART, DM};
                pg8::StaticOrder S; S.init(MTOK, DM, F.G, (int)blockIdx.x);
#ifndef NO_G2
                pg8::gemm_phase<pg8::EpiOut, pg8::StaticOrder, true, true>(F.lds, g, S, E);
#endif
            }
        }
        if (ph + 1 < hi) xcd_barrier(bar);
    }
}

#ifndef MK_N_LAUNCHES
#define MK_N_LAUNCHES 1
#endif
extern "C" void kernel_launch(void* const* d_in, const int* in_sizes, int n_in, void* d_out, int out_size, void* d_ws, size_t ws_size, hipStream_t stream) {
    static int grid = 0;
    if (grid == 0) {
        if (n_in != 17 || in_sizes[0] != MTOK * DM || out_size != MTOK * DM || ws_size < WS_END) { fprintf(stderr, "kernel_launch: unexpected shapes (n_in %d, in0 %d, out %d, ws %zu); nothing launched\n", n_in, n_in > 0 ? in_sizes[0] : -1, out_size, ws_size); grid = -1; return; }
        int dev = 0, cus = 0, per_cu = 0;
        if (hipGetDevice(&dev) != hipSuccess || hipDeviceGetAttribute(&cus, hipDeviceAttributeMultiprocessorCount, dev) != hipSuccess) { fprintf(stderr, "kernel_launch: device query failed\n"); grid = -1; return; }
        if (hipFuncSetAttribute((const void*)mk_fwd, hipFuncAttributeMaxDynamicSharedMemorySize, LDS_BYTES) != hipSuccess) { fprintf(stderr, "kernel_launch: hipFuncSetAttribute failed\n"); grid = -1; return; }
        if (hipOccupancyMaxActiveBlocksPerMultiprocessor(&per_cu, (const void*)mk_fwd, NWAVES * 64, LDS_BYTES) != hipSuccess || per_cu < 1)
            fprintf(stderr, "kernel_launch: note: occupancy query reports %d workgroups per CU\n", per_cu);
        (void)hipGetLastError();
        grid = cus;
    }
    if (grid < 0) return;
    if (hipMemsetAsync((char*)d_ws + WS_CTL, 0, CTL_ZERO_BYTES, stream) != hipSuccess) { fprintf(stderr, "kernel_launch: memset failed\n"); return; }
    Args a{};
    for (int i = 0; i < 17; ++i) a.in[i] = (const float*)d_in[i];
    a.out = (float*)d_out; a.ws = (unsigned char*)d_ws;
#if MK_N_LAUNCHES == 1
    a.ph_lo = 0; a.ph_hi = N_PHASES;
    hipLaunchKernelGGL(mk_fwd, dim3(grid), dim3(NWAVES * 64), LDS_BYTES, stream, a);
#else
    for (int ph = 0; ph < N_PHASES; ++ph) { a.ph_lo = ph; a.ph_hi = ph + 1; hipLaunchKernelGGL(mk_fwd, dim3(grid), dim3(NWAVES * 64), LDS_BYTES, stream, a); }
#endif
    const hipError_t le = hipPeekAtLastError();
    if (le != hipSuccess) fprintf(stderr, "kernel_launch: launch failed: %s\n", hipGetErrorName(le));
}
```

```cpp
#include <hip/hip_runtime.h>
#include <cstdio>
#include <cstdint>
#include <cmath>
namespace pg8 {
#define PG8_LAS __attribute__((address_space(3)))
typedef unsigned short bf16_t;
typedef short bf16x8 __attribute__((ext_vector_type(8)));
typedef float f32x4 __attribute__((ext_vector_type(4)));
typedef unsigned u32x4 __attribute__((ext_vector_type(4)));
constexpr int BM = 256, BK = 64, HALF = 128, HTB = HALF * BK * 2  , STAGE_BYTES = 8 * HTB, NXCD = 8, WGM = 8;

__host__ __device__ __forceinline__ int lds_byte(int r, int c) { const int st = (r >> 4) * 2 + (c >> 5), rr = r & 15, cc = c & 31, ob = rr * 64 + cc * 2; return st * 1024 + (ob ^ (((ob >> 9) & 1) << 5)); }
__host__ __device__ __forceinline__ void stage_rc(int b, int& R, int& C) { const int st = b / 1024, sb = b % 1024, swz = sb ^ (((sb >> 9) & 1) << 5); R = (st >> 1) * 16 + swz / 64; C = (st & 1) * 32 + (swz % 64) / 2; }
__host__ __device__ __forceinline__ int perm32(int rho) { const int n = rho >> 4, i = rho & 15; return 8 * (i >> 2) + 4 * n + (i & 3); }

struct Unit { int pm, pn; };
struct Gemm { const bf16_t* A; const bf16_t* Bt; int M, N, K; };

struct StaticOrder {
    int nM, nN, nwg, G, c;
    __host__ __device__ void init(int M, int N, int G_, int c_) { nM = M / BM; nN = N / BM; nwg = nM * nN; G = G_; c = c_; }
    __host__ __device__ bool next(int i, Unit& u) const {
        const long L = (long)i * G + c; if (L >= nwg) return false;
        int wgid = (int)L; { const int q = nwg / NXCD, r = nwg % NXCD, xcd = wgid % NXCD, off = wgid / NXCD; wgid = (xcd < r ? xcd * (q + 1) : r * (q + 1) + (xcd - r) * q) + off; }
        const int nig = WGM * nN, gid = wgid / nig, fm = gid * WGM, gsz = (nM - fm) < WGM ? (nM - fm) : WGM;
        u.pm = fm + ((wgid % nig) % gsz); u.pn = (wgid % nig) / gsz; return true;
    }
    __device__ __forceinline__ void a_ready(const Unit&) const {}
    __device__ __forceinline__ void done(const Unit&) const {}
};

__device__ __forceinline__ unsigned cvt_pk_bf16(float lo, float hi) { unsigned r; asm volatile("v_cvt_pk_bf16_f32 %0, %1, %2" : "=v"(r) : "v"(lo), "v"(hi)); return r; }
typedef float f32x2 __attribute__((ext_vector_type(2)));
#define SWZ_XOR(v, k) __uint_as_float((unsigned)__builtin_amdgcn_ds_swizzle((int)__float_as_uint(v), (((k) << 10) | 0x1F)))
__device__ __forceinline__ float red_add_x16(float v) { const auto r = __builtin_amdgcn_permlane16_swap(__float_as_uint(v), __float_as_uint(v), false, false); return __uint_as_float(r[0]) + __uint_as_float(r[1]); }
__device__ __forceinline__ float red_add_x32(float v) { const auto r = __builtin_amdgcn_permlane32_swap(__float_as_uint(v), __float_as_uint(v), false, false); return __uint_as_float(r[0]) + __uint_as_float(r[1]); }
__device__ __forceinline__ float red_max_x32(float v) { const auto r = __builtin_amdgcn_permlane32_swap(__float_as_uint(v), __float_as_uint(v), false, false); return fmaxf(__uint_as_float(r[0]), __uint_as_float(r[1])); }
__device__ __forceinline__ float red_add_g4(float v) { return red_add_x32(red_add_x16(v)); }
typedef unsigned u32x2 __attribute__((ext_vector_type(2)));
typedef __bf16 bf16x2v_t __attribute__((ext_vector_type(2)));
__device__ __forceinline__ unsigned cvt_pk_c(float lo, float hi) { const f32x2 v = {lo, hi}; return __builtin_bit_cast(unsigned, __builtin_convertvector(v, bf16x2v_t)); }
struct EpiProj {
    static constexpr bool PERM = true, AFTER_DRAIN = false;
    bf16_t* O; int ldc;
    int tm0, tm1;
    const float* part;
    const float* g0; const float* g1; const float* g2;
    int t0, t1, t2; float s0, s1, s2;
    __device__ __forceinline__ void operator()(const f32x4 (&acc)[2][2][4][2], const Unit& u, int wr, int wc, int fr, int fq) const {
        const float* gp = nullptr; float sc = 1.f;
        if (u.pn == t0) { gp = g0; sc = s0; } else if (u.pn == t1) { gp = g1; sc = s1; } else if (u.pn == t2) { gp = g2; sc = s2; }
        f32x4 gv[2][2];
#pragma unroll
        for (int bj = 0; bj < 2; ++bj)
#pragma unroll
            for (int n = 0; n < 2; ++n) gv[bj][n] = gp ? *(const f32x4*)(gp + 32 * bj + 8 * fq + 4 * n) : (f32x4){1.f, 1.f, 1.f, 1.f};
        const int row0 = u.pm * BM + wr * 64 + fr;
        const bool tokmajor = (u.pn == tm0) || (u.pn == tm1);
        bf16_t* const obase = tokmajor ? O + (size_t)u.pn * ldc * 256 + 64 * wc + 8 * fq : O + (size_t)(u.pn * 4 + wc) * ldc * 64 + 8 * fq;
        const int ostride = tokmajor ? 256 : 64;
        f32x4 pv[2][4];
        if (part) {
#pragma unroll
            for (int ai = 0; ai < 2; ++ai)
#pragma unroll
                for (int m = 0; m < 4; ++m) pv[ai][m] = *(const f32x4*)(part + (size_t)(row0 + ai * HALF + m * 16) * 16 + 4 * fq);
        }
#pragma unroll
        for (int ai = 0; ai < 2; ++ai)
#pragma unroll
            for (int m = 0; m < 4; ++m) {
                const int row = row0 + ai * HALF + m * 16;
                float rs = 1.f;
                if (part) { const f32x4 p4 = pv[ai][m]; float t = (p4[0] + p4[1]) + (p4[2] + p4[3]);
                    t = red_add_g4(t); rs = __builtin_amdgcn_rsqf(t * (1.0f / 1024.0f) + 1e-6f); }
                f32x4 v[2][2];
#pragma unroll
                for (int bj = 0; bj < 2; ++bj)
#pragma unroll
                    for (int n = 0; n < 2; ++n) v[bj][n] = acc[ai][bj][m][n] * rs;
                if (gp) {
                    float ss = 0.f;
#pragma unroll
                    for (int bj = 0; bj < 2; ++bj)
#pragma unroll
                        for (int n = 0; n < 2; ++n) { const f32x4 x = v[bj][n]; ss += (x[0] * x[0] + x[1] * x[1]) + (x[2] * x[2] + x[3] * x[3]); }
                    ss = red_add_g4(ss);
                    const float hr = sc * __builtin_amdgcn_rsqf(ss * (1.0f / 64.0f) + 1e-6f);
#pragma unroll
                    for (int bj = 0; bj < 2; ++bj)
#pragma unroll
                        for (int n = 0; n < 2; ++n) v[bj][n] = v[bj][n] * gv[bj][n] * hr;
                }
                bf16_t* rowp = obase + (size_t)row * ostride;
#pragma unroll
                for (int bj = 0; bj < 2; ++bj) { u32x4 w; w.x = cvt_pk_c(v[bj][0][0], v[bj][0][1]); w.y = cvt_pk_c(v[bj][0][2], v[bj][0][3]); w.z = cvt_pk_c(v[bj][1][0], v[bj][1][1]); w.w = cvt_pk_c(v[bj][1][2], v[bj][1][3]);
                    *(u32x4*)(rowp + 32 * bj) = w; }
            }
    }
};
struct EpiOut {
    static constexpr bool PERM = true, AFTER_DRAIN = false;
    const bf16_t* base; float* out; bf16_t* xb; float* part; int ldc;
    __device__ __forceinline__ void operator()(const f32x4 (&acc)[2][2][4][2], const Unit& u, int wr, int wc, int fr, int fq) const {
        const int col0 = u.pn * BM + wc * 32 + 8 * fq;
#pragma unroll
        for (int ai = 0; ai < 2; ++ai) {
            u32x4 bwa[4][2];
#pragma unroll
            for (int m = 0; m < 4; ++m)
#pragma unroll
                for (int bj = 0; bj < 2; ++bj) bwa[m][bj] = *(const u32x4*)(base + (size_t)(u.pm * BM + ai * HALF + wr * 64 + m * 16 + fr) * ldc + col0 + bj * HALF);
            __builtin_amdgcn_sched_barrier(0);
#pragma unroll
            for (int m = 0; m < 4; ++m) { const int row = u.pm * BM + ai * HALF + wr * 64 + m * 16 + fr; const size_t off = (size_t)row * ldc + col0; float ss = 0.f;
                const u32x4 (&bw)[2] = bwa[m];
#pragma unroll
                for (int bj = 0; bj < 2; ++bj) {
                    f32x4 o0, o1;
                    o0[0] = __uint_as_float(bw[bj].x << 16) + acc[ai][bj][m][0][0]; o0[1] = __uint_as_float(bw[bj].x & 0xffff0000u) + acc[ai][bj][m][0][1];
                    o0[2] = __uint_as_float(bw[bj].y << 16) + acc[ai][bj][m][0][2]; o0[3] = __uint_as_float(bw[bj].y & 0xffff0000u) + acc[ai][bj][m][0][3];
                    o1[0] = __uint_as_float(bw[bj].z << 16) + acc[ai][bj][m][1][0]; o1[1] = __uint_as_float(bw[bj].z & 0xffff0000u) + acc[ai][bj][m][1][1];
                    o1[2] = __uint_as_float(bw[bj].w << 16) + acc[ai][bj][m][1][2]; o1[3] = __uint_as_float(bw[bj].w & 0xffff0000u) + acc[ai][bj][m][1][3];
                    if (xb) { u32x4 w; w.x = cvt_pk_c(o0[0], o0[1]); w.y = cvt_pk_c(o0[2], o0[3]); w.z = cvt_pk_c(o1[0], o1[1]); w.w = cvt_pk_c(o1[2], o1[3]);
                        *(u32x4*)(xb + off + bj * HALF) = w;
                        ss += ((o0[0] * o0[0] + o0[1] * o0[1]) + (o0[2] * o0[2] + o0[3] * o0[3])) + ((o1[0] * o1[0] + o1[1] * o1[1]) + (o1[2] * o1[2] + o1[3] * o1[3])); }
                    else { *(f32x4*)(out + off + bj * HALF) = o0; *(f32x4*)(out + off + bj * HALF + 4) = o1; }
                }
                if (xb) { ss = red_add_g4(ss); if (fq == 0) part[(size_t)row * 16 + u.pn * 4 + wc] = ss; }
            }
        }
    }
};
template <class Epi, class Sched, bool ALIGN_EPI = false, bool SP2 = false>
__device__ __forceinline__ void gemm_phase(PG8_LAS unsigned char* lds, const Gemm g, const Sched& S, const Epi& E, int wave_id) {
    int tid_ = wave_id * 64 + (int)__builtin_amdgcn_mbcnt_hi(~0u, __builtin_amdgcn_mbcnt_lo(~0u, 0u)); asm volatile("" : "+v"(tid_));
    const int tid = tid_, wid = __builtin_amdgcn_readfirstlane(tid >> 6), lane = tid & 63, wr = wid >> 2, wc = wid & 3, fr = lane & 15, fq = lane >> 4;
    const int K = g.K, nt = K / BK;
    unsigned voffA[2], voffB[2];
#pragma unroll
    for (int i = 0; i < 2; ++i) { int R, C; stage_rc(tid * 16 + i * 8192, R, C); const int Rb = Epi::PERM ? ((R & ~31) + perm32(R & 31)) : R;
        voffA[i] = (unsigned)(R * K + C) * 2u; voffB[i] = (unsigned)(Rb * K + C) * 2u; }
    const size_t kstep = (size_t)(BK * 2);
    const size_t hstep = (size_t)HALF * K * 2;
    const size_t tstep = 2 * hstep;
    const unsigned ldsw = (unsigned)wid * 1024u;
    const int aoff = lds_byte(wr * 64 + fr, fq * 8), boff = lds_byte(wc * 32 + fr, fq * 8);
#define PG8_SA(b, h) (((b) * 2 + (h)) * HTB)
#define PG8_SB(b, h) ((4 + (b) * 2 + (h)) * HTB)
#define PG8_STAGE(bufoff, gbase, voff) do { _Pragma("unroll") for (int _i = 0; _i < 2; ++_i) \
        __builtin_amdgcn_global_load_lds((const unsigned*)((const char*)(gbase) + (voff)[_i]), (PG8_LAS unsigned*)(lds + (bufoff) + ldsw + _i * 8192), 16, 0, 0); } while (0)
#define PG8_LDA(dst, b, h) do { _Pragma("unroll") for (int m = 0; m < 4; ++m) _Pragma("unroll") for (int k = 0; k < 2; ++k) dst[m][k] = *(const PG8_LAS bf16x8*)(lds + PG8_SA(b, h) + aoff + m * 2048 + k * 1024); } while (0)
#define PG8_LDB(dst, b, h) do { _Pragma("unroll") for (int n = 0; n < 2; ++n) _Pragma("unroll") for (int k = 0; k < 2; ++k) dst[n][k] = *(const PG8_LAS bf16x8*)(lds + PG8_SB(b, h) + boff + n * 2048 + k * 1024); } while (0)
#define PG8_MMA(ai, bj, At, Bt) do { __builtin_amdgcn_s_setprio(1); _Pragma("unroll") for (int m = 0; m < 4; ++m) _Pragma("unroll") for (int n = 0; n < 2; ++n) _Pragma("unroll") for (int k = 0; k < 2; ++k) \
        acc[ai][bj][m][n] = __builtin_amdgcn_mfma_f32_16x16x32_bf16(Bt[n][k], At[m][k], acc[ai][bj][m][n], 0, 0, 0); __builtin_amdgcn_s_setprio(0); } while (0)
#define PG8_WAIT_V(n) asm volatile("s_waitcnt vmcnt(" #n ")" ::: "memory")
#define PG8_WAIT_L(n) asm volatile("s_waitcnt lgkmcnt(" #n ")" ::: "memory")
#define PG8_BAR __builtin_amdgcn_s_barrier()
#define PG8_SCHED __builtin_amdgcn_sched_barrier(0)
    Unit cur, nxt; int ui = 0;
    if (!S.next(0, cur)) return;
    f32x4 acc[2][2][4][2];
#pragma unroll
    for (int a = 0; a < 2; ++a)
#pragma unroll
        for (int b = 0; b < 2; ++b)
#pragma unroll
            for (int m = 0; m < 4; ++m)
#pragma unroll
                for (int n = 0; n < 2; ++n) acc[a][b][m][n] = (f32x4){0.f, 0.f, 0.f, 0.f};
    bf16x8 At[4][2], B0[2][2], B1[2][2];
    const char* cA = (const char*)g.A + (size_t)cur.pm * tstep; const char* cB = (const char*)g.Bt + (size_t)cur.pn * tstep;
    S.a_ready(cur);
    if constexpr (SP2) {
        PG8_STAGE(PG8_SB(0, 0), cB, voffB); PG8_STAGE(PG8_SB(0, 1), cB + hstep, voffB); PG8_STAGE(PG8_SA(0, 0), cA, voffA); PG8_STAGE(PG8_SA(0, 1), cA + hstep, voffA);
        if (wr == 1) PG8_BAR;
        PG8_WAIT_V(2); PG8_BAR;
        PG8_STAGE(PG8_SB(1, 0), cB + kstep, voffB); PG8_STAGE(PG8_SA(1, 0), cA + kstep, voffA); PG8_STAGE(PG8_SB(1, 1), cB + hstep + kstep, voffB);
        PG8_WAIT_V(6); PG8_BAR;
    } else {
        PG8_STAGE(PG8_SB(0, 0), cB, voffB); PG8_STAGE(PG8_SA(0, 0), cA, voffA); PG8_STAGE(PG8_SB(0, 1), cB + hstep, voffB); PG8_STAGE(PG8_SA(0, 1), cA + hstep, voffA);
        if (wr == 1) PG8_BAR;
        PG8_WAIT_V(4); PG8_BAR;
        PG8_STAGE(PG8_SB(1, 0), cB + kstep, voffB); PG8_STAGE(PG8_SA(1, 0), cA + kstep, voffA); PG8_STAGE(PG8_SB(1, 1), cB + hstep + kstep, voffB);
        PG8_WAIT_V(6); PG8_BAR;
    }
    for (;;) {
        const bool has_next = S.next(ui + 1, nxt);
        const char* nA = has_next ? (const char*)g.A + (size_t)nxt.pm * tstep : cA; const char* nB = has_next ? (const char*)g.Bt + (size_t)nxt.pn * tstep : cB;
        for (int t = 0; t < nt; t += 2) {
            const bool last = (t == nt - 2);
            const char* a1 = cA + (size_t)(t + 1) * kstep;
            const char* a2 = last ? nA : cA + (size_t)(t + 2) * kstep; const char* b2 = last ? nB : cB + (size_t)(t + 2) * kstep;
            const char* a3 = a2 + kstep; const char* b3 = b2 + kstep;
            if (last && has_next) S.a_ready(nxt);
            if constexpr (SP2) {
            PG8_LDB(B0, 0, 0); PG8_LDB(B1, 0, 1); PG8_SCHED; PG8_LDA(At, 0, 0); PG8_STAGE(PG8_SA(1, 1), a1 + hstep, voffA);
            PG8_WAIT_V(8); PG8_WAIT_L(0); PG8_BAR; PG8_MMA(0, 0, At, B0); PG8_MMA(0, 1, At, B1); PG8_BAR; PG8_SCHED;
            PG8_LDA(At, 0, 1); PG8_STAGE(PG8_SB(0, 0), b2, voffB); PG8_STAGE(PG8_SB(0, 1), b2 + hstep, voffB); PG8_STAGE(PG8_SA(0, 0), a2, voffA);
            PG8_WAIT_V(8); PG8_WAIT_L(0); PG8_BAR; PG8_MMA(1, 0, At, B0); PG8_MMA(1, 1, At, B1); PG8_BAR; PG8_SCHED;
            PG8_LDB(B0, 1, 0); PG8_LDB(B1, 1, 1); PG8_SCHED; PG8_LDA(At, 1, 0); PG8_STAGE(PG8_SA(0, 1), a2 + hstep, voffA);
            PG8_WAIT_V(8); PG8_WAIT_L(0); PG8_BAR; PG8_MMA(0, 0, At, B0); PG8_MMA(0, 1, At, B1); PG8_BAR; PG8_SCHED;
            PG8_LDA(At, 1, 1); PG8_STAGE(PG8_SB(1, 0), b3, voffB); PG8_STAGE(PG8_SB(1, 1), b3 + hstep, voffB); PG8_STAGE(PG8_SA(1, 0), a3, voffA);
            PG8_WAIT_V(8); PG8_WAIT_L(0); PG8_BAR; PG8_MMA(1, 0, At, B0); PG8_MMA(1, 1, At, B1); PG8_BAR; PG8_SCHED;
            } else {
            PG8_LDB(B0, 0, 0); PG8_SCHED; PG8_LDA(At, 0, 0); PG8_STAGE(PG8_SA(1, 1), a1 + hstep, voffA);
            PG8_WAIT_L(8); PG8_BAR; PG8_WAIT_L(0); PG8_MMA(0, 0, At, B0); PG8_BAR; PG8_SCHED;
            PG8_LDB(B1, 0, 1); PG8_STAGE(PG8_SB(0, 0), b2, voffB);
            PG8_BAR; PG8_WAIT_L(0); PG8_MMA(0, 1, At, B1); PG8_BAR;
            PG8_LDA(At, 0, 1); PG8_STAGE(PG8_SA(0, 0), a2, voffA);
            PG8_BAR; PG8_WAIT_L(0); PG8_MMA(1, 0, At, B0); PG8_BAR; PG8_SCHED;
            PG8_STAGE(PG8_SB(0, 1), b2 + hstep, voffB);
            PG8_WAIT_V(6); PG8_BAR; PG8_MMA(1, 1, At, B1); PG8_BAR;
            PG8_LDB(B0, 1, 0); PG8_SCHED; PG8_LDA(At, 1, 0); PG8_STAGE(PG8_SA(0, 1), a2 + hstep, voffA);
            PG8_WAIT_L(8); PG8_BAR; PG8_WAIT_L(0); PG8_MMA(0, 0, At, B0); PG8_BAR; PG8_SCHED;
            PG8_LDB(B1, 1, 1); PG8_STAGE(PG8_SB(1, 0), b3, voffB);
            PG8_BAR; PG8_WAIT_L(0); PG8_MMA(0, 1, At, B1); PG8_BAR;
            PG8_LDA(At, 1, 1); PG8_STAGE(PG8_SA(1, 0), a3, voffA);
            PG8_BAR; PG8_WAIT_L(0); PG8_MMA(1, 0, At, B0); PG8_BAR; PG8_SCHED;
            PG8_STAGE(PG8_SB(1, 1), b3 + hstep, voffB);
            PG8_WAIT_V(6); PG8_BAR; PG8_MMA(1, 1, At, B1); PG8_BAR;
            }
        }
        if constexpr (ALIGN_EPI) { if (wr == 0) PG8_BAR; }
        if constexpr (!Epi::AFTER_DRAIN) { E(acc, cur, wr, wc, fr, fq); S.done(cur); }
        if (!has_next) break;
#pragma unroll
        for (int a = 0; a < 2; ++a)
#pragma unroll
            for (int b = 0; b < 2; ++b)
#pragma unroll
                for (int m = 0; m < 4; ++m)
#pragma unroll
                    for (int n = 0; n < 2; ++n) acc[a][b][m][n] = (f32x4){0.f, 0.f, 0.f, 0.f};
        cur = nxt; cA = nA; cB = nB; ++ui;
        if constexpr (ALIGN_EPI) { if (wr == 1) PG8_BAR; }
    }
    PG8_WAIT_V(0);
    if constexpr (!ALIGN_EPI) { if (wr == 0) PG8_BAR; }
    PG8_BAR;
    if constexpr (Epi::AFTER_DRAIN) { E.fused(acc, cur, wr, wc, fr, fq, lds, wid, lane); S.done(cur); }
#undef PG8_SA
#undef PG8_SB
#undef PG8_STAGE
#undef PG8_LDA
#undef PG8_LDB
#undef PG8_MMA
#undef PG8_WAIT_V
#undef PG8_WAIT_L
#undef PG8_BAR
#undef PG8_SCHED
}
}
#define GAS __attribute__((address_space(1)))
#define LAS __attribute__((address_space(3)))
typedef unsigned short bf16;
typedef unsigned v4u __attribute__((ext_vector_type(4)));
typedef float f32x4 __attribute__((ext_vector_type(4)));
typedef short bf16x8 __attribute__((ext_vector_type(8)));
typedef GAS unsigned gu32;
typedef GAS unsigned long long gu64;
#define RLX_AGENT __ATOMIC_RELAXED, __HIP_MEMORY_SCOPE_AGENT
#define LDS_WAIT() asm volatile("s_waitcnt lgkmcnt(0)" ::: "memory")
#define VM_WAIT() asm volatile("s_waitcnt vmcnt(0)" ::: "memory")
__device__ __forceinline__ unsigned long long rt() { return __builtin_amdgcn_s_memrealtime(); }
__device__ __forceinline__ unsigned f2bf(float f) { unsigned u = __builtin_bit_cast(unsigned, f); return (u + 0x7fffu + ((u >> 16) & 1u)) >> 16; }
__device__ __forceinline__ unsigned pk2(float lo, float hi) { return f2bf(lo) | (f2bf(hi) << 16); }

#define XB_TMO      128
#define XB_XCNT(j)  (256  + 64 * (j))
#define XB_XSUB(j)  (1280 + 64 * (j))
#define XB_XGEN(j)  (2304 + 64 * (j))
#define XB_TOP      3328
#define XB_TOPGEN   3392
#define XCD_BAR_WORDS 3456
#define XB_SPIN_CAP (1u << 18)

__device__ __forceinline__ unsigned xb_ld(unsigned* p)              { return __hip_atomic_load(p, __ATOMIC_RELAXED, __HIP_MEMORY_SCOPE_AGENT); }
__device__ __forceinline__ unsigned xb_add(unsigned* p, unsigned v) { return __hip_atomic_fetch_add(p, v, __ATOMIC_RELAXED, __HIP_MEMORY_SCOPE_AGENT); }
__device__ __forceinline__ unsigned xb_xcc_id() { return (unsigned)__builtin_amdgcn_s_getreg((3 << 11) | 20) & 0xFu; }
#define XB_SPIN(cond, bar) do { unsigned _sp = 0; while (cond) { __builtin_amdgcn_s_sleep(1); \
    if ((++_sp & 255u) == 0u) { if (xb_ld(&(bar)[XB_TMO])) break; if (_sp > XB_SPIN_CAP) { atomicAdd(&(bar)[XB_TMO], 1u); break; } } } } while (0)

struct XcdBarrier {
    unsigned* bar; unsigned x;
    volatile LAS unsigned* st;
};

__device__ __forceinline__ XcdBarrier xcd_barrier_post(unsigned* bar, volatile LAS unsigned* st) {
    XcdBarrier b; b.bar = bar; b.x = xb_xcc_id(); b.st = st;
    if (threadIdx.x == 0) (void)xb_add(&bar[XB_XCNT(b.x)], 1u);
    return b;
}
__device__ __forceinline__ void xcd_barrier_complete(unsigned* bar, unsigned x, unsigned& nloc, unsigned& nx) {
    const unsigned G = gridDim.x * gridDim.y * gridDim.z;
    unsigned sum, cnt, mine, sp = 0u;
    for (;;) {
        sum = 0u; cnt = 0u; mine = 0u;
#pragma unroll
        for (unsigned j = 0; j < 16; ++j) { const unsigned c = xb_ld(&bar[XB_XCNT(j)]); sum += c; cnt += (c > 0u) ? 1u : 0u; mine = (j == x) ? c : mine; }
        if (sum == G) break;
        __builtin_amdgcn_s_sleep(1);
        if ((++sp & 255u) == 0u) { if (xb_ld(&bar[XB_TMO])) break; if (sp > XB_SPIN_CAP) { atomicAdd(&bar[XB_TMO], 1u); break; } }
    }
    nloc = mine > 0u ? mine : 1u; nx = cnt > 0u ? cnt : 1u;
}

__device__ __forceinline__ void xcd_barrier(const XcdBarrier& b) {
    asm volatile("s_waitcnt vmcnt(0)" ::: "memory");
    __syncthreads();
    if (threadIdx.x == 0) {
        unsigned* bar = b.bar;
        __builtin_amdgcn_s_waitcnt(0);
        unsigned nloc = b.st[0], nx = b.st[1];
        if (nloc == 0u) { xcd_barrier_complete(bar, b.x, nloc, nx); b.st[0] = nloc; b.st[1] = nx; }
        const unsigned old = xb_add(&bar[XB_XSUB(b.x)], 1u);
        const unsigned gen = old / nloc;
        if (old + 1u == (gen + 1u) * nloc) {
            __builtin_amdgcn_fence(__ATOMIC_RELEASE, "agent");
            asm volatile("s_waitcnt vmcnt(0)" ::: "memory");
            const unsigned og = xb_add(&bar[XB_TOP], 1u);
            const unsigned tg = og / nx;
            if (og + 1u == (tg + 1u) * nx) xb_add(&bar[XB_TOPGEN], 1u);
            else XB_SPIN(xb_ld(&bar[XB_TOPGEN]) == tg, bar);
            __builtin_amdgcn_fence(__ATOMIC_ACQUIRE, "agent");
            xb_add(&bar[XB_XGEN(b.x)], 1u);
            asm volatile("s_waitcnt vmcnt(0)" ::: "memory");
        } else {
            XB_SPIN(xb_ld(&bar[XB_XGEN(b.x)]) == gen, bar);
            __builtin_amdgcn_fence(__ATOMIC_ACQUIRE, "agent");
            asm volatile("s_waitcnt vmcnt(0)" ::: "memory");
        }
    }
    __syncthreads();
}

constexpr int NWAVES = 8;
constexpr int BATCH = 8, SEQ = 4096, DM = 1024, MTOK = BATCH * SEQ, NMEM = 256, MEMROWS = BATCH * NMEM;
constexpr int NPROJ = 3072;
enum { S_AU = 0, S_AV = 1, S_AG = 2, S_BQ = 3, S_BK = 4, S_BV = 5, S_BG = 6, S_XC = 7, S_XS = 8, S_CG = 9, S_DQ = 10, S_DG = 11 };
constexpr float LOG2E = 1.4426950408889634f;
constexpr float QSCALE = 0.125f * LOG2E;
constexpr int IN_COLS = 2816;

constexpr size_t MiB = 1u << 20;
constexpr size_t WS_CTL = 0, CTL_ZERO_BYTES = 64 * 1024;
constexpr size_t WS_WIN = 2 * MiB;
constexpr size_t WS_WOUT = 14 * MiB;
constexpr size_t WS_WMKV = 18 * MiB;
constexpr size_t WS_WS = 20 * MiB;
constexpr size_t WS_F1 = 20 * MiB + 512 * 1024;
constexpr size_t WS_F2 = WS_F1 + 64 * 1024;
constexpr size_t WS_TW = WS_F2 + 64 * 1024;
constexpr size_t WS_BND = WS_TW + 64 * 1024;
constexpr size_t WS_MEMA = 22 * MiB;
constexpr size_t WS_MKV = 26 * MiB;
constexpr size_t WS_PART = 30 * MiB;
constexpr size_t WS_XB = 32 * MiB;
constexpr size_t WS_P = 96 * MiB;
constexpr size_t WS_Y = 288 * MiB;
constexpr size_t WS_T = 352 * MiB;
constexpr size_t WS_END = 384 * MiB;
constexpr int CW_BAR = 4096;

constexpr int RING_BYTES = 131072;
constexpr int ATT_K_OFF = 0, ATT_IMG_BYTES = 9 * 64 * 128, ATT_V_OFF = ATT_IMG_BYTES, ATT_BT_OFF = 2 * ATT_IMG_BYTES;
constexpr int LDSCTL_OFF = 155 * 1024, MISC_OFF = LDSCTL_OFF + 320;
constexpr int LDS_BYTES = 156 * 1024;
static_assert(ATT_BT_OFF + 15 * 32 * 4 <= LDSCTL_OFF && MISC_OFF + 128 <= LDS_BYTES, "LDS map");

typedef short s16x4 __attribute__((ext_vector_type(4)));
typedef unsigned u32x2v __attribute__((ext_vector_type(2)));

typedef const float* cfptr_t;
typedef const __attribute__((address_space(4))) cfptr_t* kargtab;
struct Frame {
    LAS unsigned char* lds;
    volatile LAS unsigned* MISC;
    gu32* ctl;
    int tid, lane, wave, vcu, G;
    kargtab in;
    float* out; unsigned char* ws;
};
enum { I_X = 0, I_MEM, I_NORMG, I_WIN, I_WOUT, I_LNG, I_LNB, I_WS, I_BS, I_NAQ, I_NAK, I_RPB, I_FNW, I_MEMNG, I_WMKV, I_MQ, I_MK };

constexpr size_t PLANE = (size_t)MTOK * 64;
__device__ __forceinline__ const bf16* pplane(const bf16* P, int slot, int h) { return P + (size_t)(slot * 4 + h) * PLANE; }
__device__ __forceinline__ const bf16* ptok(const bf16* P, int slot) { return P + (size_t)slot * 4 * PLANE; }
__device__ __forceinline__ float bf_lo(unsigned w) { return __uint_as_float(w << 16); }
__device__ __forceinline__ float bf_hi(unsigned w) { return __uint_as_float(w & 0xffff0000u); }
__device__ __forceinline__ unsigned pkbf(float lo, float hi) { return pg8::cvt_pk_bf16(lo, hi); }
__device__ __forceinline__ float silu_f(float x) { return x * __builtin_amdgcn_rcpf(1.0f + __builtin_amdgcn_exp2f(-LOG2E * x)); }
__device__ __forceinline__ float wave_sum(float v) {
    v += SWZ_XOR(v, 1); v += SWZ_XOR(v, 2); v += SWZ_XOR(v, 4); v += SWZ_XOR(v, 8); v += SWZ_XOR(v, 16);
    return pg8::red_add_x32(v);
}
__device__ __forceinline__ float wave_max(float v) {
    v = fmaxf(v, SWZ_XOR(v, 1)); v = fmaxf(v, SWZ_XOR(v, 2)); v = fmaxf(v, SWZ_XOR(v, 4)); v = fmaxf(v, SWZ_XOR(v, 8)); v = fmaxf(v, SWZ_XOR(v, 16));
    return pg8::red_max_x32(v);
}
__device__ __forceinline__ s16x4 tr_read(LAS const unsigned char* p) {
    typedef short v4i16_t __attribute__((ext_vector_type(4)));
    return __builtin_bit_cast(s16x4, __builtin_amdgcn_ds_read_tr16_b64_v4i16((LAS v4i16_t*)p));
}

__device__ __forceinline__ void tr_store(LAS const float* scr, bf16* dst, int K, int lane) {
    const int c = lane & 7;
#pragma unroll
    for (int j = 0; j < 4; ++j) { const int n = (lane >> 3) + 8 * j; const LAS float* s = scr + (8 * c) * 33 + n;
        v4u o; o.x = pkbf(s[0 * 33], s[1 * 33]); o.y = pkbf(s[2 * 33], s[3 * 33]); o.z = pkbf(s[4 * 33], s[5 * 33]); o.w = pkbf(s[6 * 33], s[7 * 33]);
        *(GAS v4u*)(dst + (size_t)n * K + 8 * c) = o; }
}
__device__ __forceinline__ void tr_plain_issue(const float* src, int ld, int lane, f32x4 (&v)[8]) {
#pragma unroll
    for (int it = 0; it < 8; ++it) v[it] = __builtin_nontemporal_load((const GAS f32x4*)(src + (size_t)(8 * it + (lane >> 3)) * ld + 4 * (lane & 7)));
}
__device__ __forceinline__ void tr_plain_finish(const f32x4 (&v)[8], const float* gk, bf16* dst, int K, LAS float* scr, int lane) {
#pragma unroll
    for (int it = 0; it < 8; ++it) { const int kk = 8 * it + (lane >> 3); const float g = gk ? gk[kk] : 1.0f; LAS float* d = scr + kk * 33 + 4 * (lane & 7);
        d[0] = v[it][0] * g; d[1] = v[it][1] * g; d[2] = v[it][2] * g; d[3] = v[it][3] * g; }
    LDS_WAIT(); asm volatile("" ::: "memory");
    tr_store(scr, dst, K, lane);
    LDS_WAIT(); asm volatile("" ::: "memory");
}
typedef float f32x16 __attribute__((ext_vector_type(16)));
__device__ __forceinline__ void tr_item_fold(const float* winrow  , const float* gk, const float* wf  , LAS const float* tab  ,
                                             bf16* dst, LAS float* scr, LAS float* scr2, int lane) {
    const int i = lane & 31, hk = lane >> 5;
    {   float wb[32];
#pragma unroll
        for (int s = 0; s < 32; ++s) wb[s] = wf[(32 * hk + s) * 64 + i];
#pragma nounroll
        for (int mt = 0; mt < 2; ++mt) {
            f32x16 m0 = {};
#pragma unroll
            for (int s = 0; s < 32; ++s) m0 = __builtin_amdgcn_mfma_f32_32x32x2f32(tab[((32 * mt + i) * (32 * hk + s)) & 63], wb[s], m0, 0, 0, 0);
#pragma unroll
            for (int r = 0; r < 16; ++r) { const int d = 32 * mt + (r & 3) + 8 * (r >> 2) + 4 * hk; scr2[d * 33 + i] = m0[r] * 0.125f; }
        }
    }
    LDS_WAIT(); asm volatile("" ::: "memory");
#pragma nounroll
    for (int mt = 0; mt < 2; ++mt) {
        f32x4 wv[8];
#pragma unroll
        for (int j = 0; j < 8; ++j) wv[j] = *(const GAS f32x4*)(winrow + (size_t)(32 * mt + i) * IN_COLS + 32 * hk + 4 * j);
        f32x16 a0 = {};
#pragma unroll
        for (int s = 0; s < 32; ++s) a0 = __builtin_amdgcn_mfma_f32_32x32x2f32(wv[s >> 2][s & 3], scr2[(32 * hk + s) * 33 + i], a0, 0, 0, 0);
#pragma unroll
        for (int r = 0; r < 16; ++r) { const int kk = 32 * mt + (r & 3) + 8 * (r >> 2) + 4 * hk; scr[kk * 33 + i] = a0[r] * gk[kk]; }
    }
    LDS_WAIT(); asm volatile("" ::: "memory");
    tr_store(scr, dst, 1024, lane);
    LDS_WAIT(); asm volatile("" ::: "memory");
}
__device__ __forceinline__ int src_col_of_slot(int t) { return t <= 6 ? 256 * t : (t == 9 ? 2048 : (t == 10 ? 2304 : 2560)); }

struct ItemDesc { const float* src; const float* gk; const float* wf; bf16* dst; int ld; int kind; int sel; };
__device__ __forceinline__ void p0_item_decode(Frame& F, int it, ItemDesc& d) {
    bf16* WinT = (bf16*)(F.ws + WS_WIN); bf16* WoutT = (bf16*)(F.ws + WS_WOUT); bf16* WmkvT = (bf16*)(F.ws + WS_WMKV);
    constexpr int N_IN = 2 * 16 * 96, N_OUT = 2 * 16 * 32, N_KV = 2 * 16 * 16;
    int r = it; d.kind = 0; d.wf = nullptr; d.sel = 0; d.gk = nullptr; d.src = nullptr; d.dst = nullptr; d.ld = 0;
    if (r >= N_IN + N_OUT + N_KV) { d.kind = -1; return; }
    if (r < N_IN) { const int l = r / 1536; r -= l * 1536; const int kb = r / 96, nb = r % 96, pn = nb >> 3, bj = (nb >> 2) & 1, wc = nb & 3, k0 = 64 * kb;
        d.dst = WinT + ((size_t)l * NPROJ + 32 * nb) * 1024 + k0; d.gk = F.in[I_NORMG] + l * 1024 + k0; d.ld = IN_COLS;
        const float* win = F.in[I_WIN] + (size_t)l * 1024 * IN_COLS + (size_t)k0 * IN_COLS;
        if (pn == S_XC || pn == S_XS) { d.kind = 1; d.sel = (pn == S_XS); d.src = win + 1792 + 64 * wc; d.wf = F.in[I_FNW] + (size_t)((l * 4 + wc) * 64) * 64 + 32 * bj; }
        else d.src = win + src_col_of_slot(pn) + 64 * wc + 32 * bj;
        return; }
    r -= N_IN;
    if (r < N_OUT) { const int l = r / 512; r -= l * 512; const int kb = r / 32, nb = r % 32, k0 = 64 * kb;
        d.src = F.in[I_WOUT] + (size_t)l * 1024 * 1024 + (size_t)k0 * 1024 + 32 * nb; d.ld = 1024; d.dst = WoutT + ((size_t)l * 1024 + 32 * nb) * 1024 + k0; return; }
    r -= N_OUT;
    { const int l = r / 256; r -= l * 256; const int kb = r / 16, nb = r % 16, k0 = 64 * kb;
      d.src = F.in[I_WMKV] + (size_t)l * 1024 * 512 + (size_t)k0 * 512 + 32 * nb; d.ld = 512; d.gk = F.in[I_MEMNG] + l * 1024 + k0; d.dst = WmkvT + ((size_t)l * 512 + 32 * nb) * 1024 + k0; }
}
#define FRESH_BASES(F) do { unsigned char* w_ = (F).ws; float* o_ = (F).out; kargtab i_ = (F).in; asm volatile("" : "+s"(w_), "+s"(o_), "+s"(i_)); (F).ws = w_; (F).out = o_; (F).in = i_; (F).ctl = (gu32*)(w_ + WS_CTL); } while (0)
#define FRESH_LANES(F) do { int t_ = (F).wave * 64 + (int)__builtin_amdgcn_mbcnt_hi(~0u, __builtin_amdgcn_mbcnt_lo(~0u, 0u)); asm volatile("" : "+v"(t_)); (F).tid = t_; (F).lane = t_ & 63; FRESH_BASES(F); } while (0)
__device__ __forceinline__ void p0_prologue(Frame& F) {
    FRESH_LANES(F);
    LAS float* tabc = (LAS float*)(F.lds + 8 * 16896);
    LAS float* tabs = tabc + 64;
    if (F.tid < 64) { float s, c; sincospif((float)F.tid * (1.0f / 32.0f), &s, &c); tabc[F.tid] = c; tabs[F.tid] = s; }
    __syncthreads();
    LAS float* scr = (LAS float*)(F.lds + F.wave * 16896);
    LAS float* scr2 = scr + 64 * 33;
    constexpr int NHW = NWAVES / 2;
    const bool xrole = F.wave < NHW;
    const int gw = F.vcu * NHW + (F.wave & (NHW - 1)), NGW = F.G * NHW;
    bf16* WinT = (bf16*)(F.ws + WS_WIN); bf16* WoutT = (bf16*)(F.ws + WS_WOUT); bf16* WmkvT = (bf16*)(F.ws + WS_WMKV);
    if (xrole) { bf16* XB = (bf16*)(F.ws + WS_XB); float* part = (float*)(F.ws + WS_PART);
#define X_ISSUE(V, M0) do { if ((M0) < MTOK) { _Pragma("unroll") for (int r = 0; r < 4; ++r) { const GAS f32x4* xr = (const GAS f32x4*)(F.in[I_X] + (size_t)((M0) + r) * DM) + 2 * F.lane; \
            (V)[r][0] = __builtin_nontemporal_load(xr); (V)[r][1] = __builtin_nontemporal_load(xr + 1); (V)[r][2] = __builtin_nontemporal_load(xr + 128); (V)[r][3] = __builtin_nontemporal_load(xr + 129); } } } while (0)
#define X_FINISH(V, M0) do { if ((M0) < MTOK) { _Pragma("unroll") for (int r = 0; r < 4; ++r) { float s_ = 0.f; \
            _Pragma("unroll") for (int j = 0; j < 4; ++j) s_ += ((V)[r][j][0] * (V)[r][j][0] + (V)[r][j][1] * (V)[r][j][1]) + ((V)[r][j][2] * (V)[r][j][2] + (V)[r][j][3] * (V)[r][j][3]); \
            s_ = wave_sum(s_); \
            GAS v4u* o16 = (GAS v4u*)(XB + (size_t)((M0) + r) * DM) + F.lane; \
            v4u w0, w1; w0.x = pkbf((V)[r][0][0], (V)[r][0][1]); w0.y = pkbf((V)[r][0][2], (V)[r][0][3]); w0.z = pkbf((V)[r][1][0], (V)[r][1][1]); w0.w = pkbf((V)[r][1][2], (V)[r][1][3]); \
            w1.x = pkbf((V)[r][2][0], (V)[r][2][1]); w1.y = pkbf((V)[r][2][2], (V)[r][2][3]); w1.z = pkbf((V)[r][3][0], (V)[r][3][1]); w1.w = pkbf((V)[r][3][2], (V)[r][3][3]); \
            o16[0] = w0; o16[64] = w1; \
            if (F.lane < 4) *(GAS f32x4*)(part + (size_t)((M0) + r) * 16 + 4 * F.lane) = (f32x4){F.lane == 0 ? s_ : 0.f, 0.f, 0.f, 0.f}; } } } while (0)
      const int step = NGW * 4;
      f32x4 va[4][4], vb[4][4];
      X_ISSUE(va, gw * 4);
      for (int m0 = gw * 4; m0 < MTOK; m0 += 2 * step) {
          X_ISSUE(vb, m0 + step);
          X_FINISH(va, m0);
          X_ISSUE(va, m0 + 2 * step);
          X_FINISH(vb, m0 + step);
      }
#undef X_ISSUE
#undef X_FINISH
    } else {
    {   ItemDesc d0, d1, d2; f32x4 i0[8], i1[8], i2[8];
        p0_item_decode(F, gw, d0); p0_item_decode(F, gw + NGW, d1); p0_item_decode(F, gw + 2 * NGW, d2);
        if (d0.kind == 0) tr_plain_issue(d0.src, d0.ld, F.lane, i0);
        if (d1.kind == 0) tr_plain_issue(d1.src, d1.ld, F.lane, i1);
        if (d2.kind == 0) tr_plain_issue(d2.src, d2.ld, F.lane, i2);
        if (d0.kind == 0) tr_plain_finish(i0, d0.gk, d0.dst, 1024, scr, F.lane);
        if (d1.kind == 0) tr_plain_finish(i1, d1.gk, d1.dst, 1024, scr, F.lane);
        if (d2.kind == 0) tr_plain_finish(i2, d2.gk, d2.dst, 1024, scr, F.lane);
        if (d0.kind == 1) tr_item_fold(d0.src, d0.gk, d0.wf, d0.sel ? tabs : tabc, d0.dst, scr, scr2, F.lane);
        if (d1.kind == 1) tr_item_fold(d1.src, d1.gk, d1.wf, d1.sel ? tabs : tabc, d1.dst, scr, scr2, F.lane);
        if (d2.kind == 1) tr_item_fold(d2.src, d2.gk, d2.wf, d2.sel ? tabs : tabc, d2.dst, scr, scr2, F.lane);
    }
    {   ItemDesc d0, d1; f32x4 i0[8], i1[8];
        p0_item_decode(F, gw + 3 * NGW, d0); p0_item_decode(F, gw + 4 * NGW, d1);
        if (d0.kind == 0) tr_plain_issue(d0.src, d0.ld, F.lane, i0);
        if (d1.kind == 0) tr_plain_issue(d1.src, d1.ld, F.lane, i1);
        if (d0.kind == 0) tr_plain_finish(i0, d0.gk, d0.dst, 1024, scr, F.lane);
        if (d1.kind == 0) tr_plain_finish(i1, d1.gk, d1.dst, 1024, scr, F.lane);
        if (d0.kind == 1) tr_item_fold(d0.src, d0.gk, d0.wf, d0.sel ? tabs : tabc, d0.dst, scr, scr2, F.lane);
        if (d1.kind == 1) tr_item_fold(d1.src, d1.gk, d1.wf, d1.sel ? tabs : tabc, d1.dst, scr, scr2, F.lane);
        for (int it = gw + 5 * NGW; it < 2 * 16 * 96 + 2 * 16 * 32 + 2 * 16 * 16; it += NGW) {
            ItemDesc d; p0_item_decode(F, it, d);
            if (d.kind == 1) tr_item_fold(d.src, d.gk, d.wf, d.sel ? tabs : tabc, d.dst, scr, scr2, F.lane);
            else if (d.kind == 0) { f32x4 iv[8]; tr_plain_issue(d.src, d.ld, F.lane, iv); tr_plain_finish(iv, d.gk, d.dst, 1024, scr, F.lane); } }
    }
    { bf16* WsB = (bf16*)(F.ws + WS_WS); const float* ws_in = F.in[I_WS];
      for (int i = gw * 64 + F.lane; i < 2 * 4 * 128 * 128 / 2; i += NGW * 64) ((GAS unsigned*)WsB)[i] = pkbf(ws_in[2 * i], ws_in[2 * i + 1]);
      bf16* F1 = (bf16*)(F.ws + WS_F1);
      for (int i = gw * 64 + F.lane; i < 128 * 128; i += NGW * 64) { const int m = i >> 7, kk = i & 127, part = m >> 6, k1 = m & 63, src = kk >> 6, s1 = kk & 63;
          float s, c; sincospif((float)((k1 * s1) & 63) * (1.0f / 32.0f), &s, &c);
          const float v = (part == 0) ? (src == 0 ? c : -s) : (src == 0 ? -s : -c);
          F1[i] = (bf16)(pkbf(v * 0.125f, 0.f) & 0xffffu); }
      bf16* F2 = (bf16*)(F.ws + WS_F2);
      for (int i = gw * 64 + F.lane; i < 64 * 128; i += NGW * 64) { const int k2 = i >> 7, kk = i & 127, src = kk >> 6, s2 = kk & 63;
          float s, c; sincospif((float)((k2 * s2) & 63) * (1.0f / 32.0f), &s, &c);
          F2[i] = (bf16)(pkbf((src == 0 ? c : s) * 0.125f, 0.f) & 0xffffu); }
      float* TW = (float*)(F.ws + WS_TW);
      for (int i = gw * 64 + F.lane; i < 64 * 64; i += NGW * 64) { const int s2 = i >> 6, k1 = i & 63; float s, c; sincospif((float)(s2 * k1) * (1.0f / 2048.0f), &s, &c); TW[2 * i] = c; TW[2 * i + 1] = s; }
    }
    if (gw < 12) { const int l = gw / 6, j = gw % 6; float* BND = (float*)(F.ws + WS_BND) + 8 * l;
        if (j < 2) { const float a = wave_max(fabsf((j == 0 ? F.in[I_NAK] : F.in[I_MK])[64 * l + F.lane])); if (F.lane == 0) BND[j] = 8.08f * a; }
        else { const int h = j - 2; float v[8];
#pragma unroll
            for (int k = 0; k < 8; ++k) { const int i = F.lane + 64 * k; v[k] = i < 15 * 31 ? fabsf(F.in[I_RPB][(l * 4 + h) * 15 * 31 + i]) : 0.f; }
            float m = fmaxf(fmaxf(fmaxf(v[0], v[1]), fmaxf(v[2], v[3])), fmaxf(fmaxf(v[4], v[5]), fmaxf(v[6], v[7])));
            m = wave_max(m); if (F.lane == 0) BND[2 + h] = LOG2E * m; }
    }
    { bf16* memA = (bf16*)(F.ws + WS_MEMA);
      for (int m = gw; m < MEMROWS; m += NGW) { const GAS f32x4* xr = (const GAS f32x4*)(F.in[I_MEM] + (size_t)m * DM) + F.lane; f32x4 v[4]; float s = 0.f;
#pragma unroll
          for (int j = 0; j < 4; ++j) { v[j] = __builtin_nontemporal_load(xr + 64 * j); s += (v[j][0] * v[j][0] + v[j][1] * v[j][1]) + (v[j][2] * v[j][2] + v[j][3] * v[j][3]); }
          const float rstd = 1.0f / sqrtf(wave_sum(s) * (1.0f / DM) + 1e-6f);
          GAS u32x2v* o8 = (GAS u32x2v*)(memA + (size_t)m * DM) + F.lane;
#pragma unroll
          for (int j = 0; j < 4; ++j) { u32x2v w; w.x = pkbf(v[j][0] * rstd, v[j][1] * rstd); w.y = pkbf(v[j][2] * rstd, v[j][3] * rstd); o8[64 * j] = w; } }
    }
    }
}

constexpr int IMG_BYTES = 65536;
__device__ __forceinline__ int img_swz(int row) { return ((row & 3) << 5) | (((row >> 3) & 1) << 7); }
template <int NT>
__device__ __forceinline__ void spatial_core(LAS const unsigned char* img, const bf16x8 (&bw)[4][NT], int chbase, int lane, f32x4 (&acc)[4][NT]) {
    const int g = lane >> 4, r = lane & 15, q = r >> 2, p = r & 3;
    const int sw = (q << 5) | ((g & 1) << 7);
#pragma unroll
    for (int mt = 0; mt < 4; ++mt)
#pragma unroll
        for (int nt = 0; nt < NT; ++nt) acc[mt][nt] = (f32x4){0.f, 0.f, 0.f, 0.f};
#pragma unroll
    for (int ks = 0; ks < 4; ++ks) {
        const int row0 = ks * 32 + g * 8 + q;
#pragma unroll
        for (int mt = 0; mt < 4; ++mt) {
            const int cb = (2 * chbase + 64 * (mt >> 1) + 16 * p + 8 * (mt & 1)) ^ sw;
            const s16x4 lo = tr_read(img + row0 * 512 + cb), hi = tr_read(img + (row0 + 4) * 512 + cb);
            const bf16x8 av = (bf16x8){lo[0], lo[1], lo[2], lo[3], hi[0], hi[1], hi[2], hi[3]};
#pragma unroll
            for (int nt = 0; nt < NT; ++nt) acc[mt][nt] = __builtin_amdgcn_mfma_f32_16x16x32_bf16(av, bw[ks][nt], acc[mt][nt], 0, 0, 0);
        }
    }
}
template <int NT>
__device__ __forceinline__ void spatial_core_stream(LAS const unsigned char* img, const bf16* Amat, const int (&arow)[NT], int chbase, int lane, f32x4 (&acc)[4][NT]) {
    const int g = lane >> 4, r = lane & 15, q = r >> 2, p = r & 3;
    const int sw = (q << 5) | ((g & 1) << 7);
#pragma unroll
    for (int mt = 0; mt < 4; ++mt)
#pragma unroll
        for (int nt = 0; nt < NT; ++nt) acc[mt][nt] = (f32x4){0.f, 0.f, 0.f, 0.f};
    bf16x8 bwc[NT], bwn[NT];
#pragma unroll
    for (int nt = 0; nt < NT; ++nt) bwc[nt] = *(const GAS bf16x8*)(Amat + (size_t)(arow[nt] + r) * 128 + g * 8);
#pragma unroll
    for (int ks = 0; ks < 4; ++ks) {
        if (ks < 3) {
#pragma unroll
            for (int nt = 0; nt < NT; ++nt) bwn[nt] = *(const GAS bf16x8*)(Amat + (size_t)(arow[nt] + r) * 128 + (ks + 1) * 32 + g * 8); }
        const int row0 = ks * 32 + g * 8 + q;
#pragma unroll
        for (int mt = 0; mt < 4; ++mt) {
            const int cb = (2 * chbase + 64 * (mt >> 1) + 16 * p + 8 * (mt & 1)) ^ sw;
            const s16x4 lo = tr_read(img + row0 * 512 + cb), hi = tr_read(img + (row0 + 4) * 512 + cb);
            const bf16x8 av = (bf16x8){lo[0], lo[1], lo[2], lo[3], hi[0], hi[1], hi[2], hi[3]};
#pragma unroll
            for (int nt = 0; nt < NT; ++nt) acc[mt][nt] = __builtin_amdgcn_mfma_f32_16x16x32_bf16(av, bwc[nt], acc[mt][nt], 0, 0, 0);
        }
#pragma unroll
        for (int nt = 0; nt < NT; ++nt) bwc[nt] = bwn[nt];
    }
}
#define LOAD_BW(BW, NT_, AMAT, AROW) do { _Pragma("unroll") for (int ks_ = 0; ks_ < 4; ++ks_) _Pragma("unroll") for (int nt_ = 0; nt_ < (NT_); ++nt_) \
    (BW)[ks_][nt_] = *(const GAS bf16x8*)((AMAT) + (size_t)((AROW)[nt_] + (F.lane & 15)) * 128 + ks_ * 32 + (F.lane >> 4) * 8); } while (0)
struct ImgRegs { v4u r[8]; };
#define IMG_ISSUE(R, ROWPTR_EXPR) do { _Pragma("unroll") for (int it_ = 0; it_ < 8; ++it_) { const int id_ = F.tid + 512 * it_, kk = id_ >> 5, c_ = id_ & 31; \
        (R).r[it_] = *(const GAS v4u*)((ROWPTR_EXPR) + 8 * c_); } } while (0)
#define IMG_COMMIT(R, IMG) do { _Pragma("unroll") for (int it_ = 0; it_ < 8; ++it_) { const int id_ = F.tid + 512 * it_, kk = id_ >> 5, c_ = id_ & 31; \
        *(LAS v4u*)((IMG) + kk * 512 + ((16 * c_) ^ img_swz(kk))) = (R).r[it_]; } } while (0)

__device__ __forceinline__ void store8bf(bf16* p, const f32x4& a, const f32x4& b) { v4u w; w.x = pkbf(a[0], a[1]); w.y = pkbf(a[2], a[3]); w.z = pkbf(b[0], b[1]); w.w = pkbf(b[2], b[3]); *(GAS v4u*)p = w; }
__device__ __forceinline__ void load8bf(const bf16* p, f32x4& a, f32x4& b) { const v4u w = *(const GAS v4u*)p; a[0] = bf_lo(w.x); a[1] = bf_hi(w.x); a[2] = bf_lo(w.y); a[3] = bf_hi(w.y); b[0] = bf_lo(w.z); b[1] = bf_hi(w.z); b[2] = bf_lo(w.w); b[3] = bf_hi(w.w); }
__device__ __forceinline__ f32x4 silu4(const f32x4& x) { return (f32x4){silu_f(x[0]), silu_f(x[1]), silu_f(x[2]), silu_f(x[3])}; }
__device__ __forceinline__ void store4bf(bf16* p, float a, float b, float c, float d) { u32x2v w; w.x = pkbf(a, b); w.y = pkbf(c, d); *(GAS u32x2v*)p = w; }
__device__ __forceinline__ void load4bf(const bf16* p, float (&o)[4]) { const u32x2v w = *(const GAS u32x2v*)p; o[0] = bf_lo(w.x); o[1] = bf_hi(w.x); o[2] = bf_lo(w.y); o[3] = bf_hi(w.y); }

__device__ __forceinline__ void gmlp_issue(Frame& F, ImgRegs& R, int b, int chunk) {
    const bf16* P = (const bf16*)(F.ws + WS_P); const int tok0 = b * SEQ + 128 * chunk, l32 = F.lane & 31, half = F.lane >> 5;
#pragma unroll
    for (int it = 0; it < 8; ++it) R.r[it] = *(const GAS v4u*)(pplane(P, S_AV, l32 >> 3) + (size_t)(tok0 + 16 * F.wave + 2 * it + half) * 64 + 8 * (l32 & 7));
}
__device__ __forceinline__ void gmlp_commit(Frame& F, const ImgRegs& R, LAS unsigned char* img, int l) {
    const int l32 = F.lane & 31, half = F.lane >> 5, c0 = 8 * l32;
    float lg[8], lb[8];
#pragma unroll
    for (int j = 0; j < 8; ++j) { lg[j] = F.in[I_LNG][l * 256 + c0 + j]; lb[j] = F.in[I_LNB][l * 256 + c0 + j]; }
#pragma unroll
    for (int it = 0; it < 8; ++it) { const int tl = 16 * F.wave + 2 * it + half; const v4u raw = R.r[it];
        float x[8] = {bf_lo(raw.x), bf_hi(raw.x), bf_lo(raw.y), bf_hi(raw.y), bf_lo(raw.z), bf_hi(raw.z), bf_lo(raw.w), bf_hi(raw.w)};
        float s = ((x[0] + x[1]) + (x[2] + x[3])) + ((x[4] + x[5]) + (x[6] + x[7]));
        s += SWZ_XOR(s, 1); s += SWZ_XOR(s, 2); s += SWZ_XOR(s, 4); s += SWZ_XOR(s, 8); s += SWZ_XOR(s, 16);
        const float mean = s * (1.0f / 256.0f); float v = 0.f;
#pragma unroll
        for (int j = 0; j < 8; ++j) { x[j] -= mean; v += x[j] * x[j]; }
        v += SWZ_XOR(v, 1); v += SWZ_XOR(v, 2); v += SWZ_XOR(v, 4); v += SWZ_XOR(v, 8); v += SWZ_XOR(v, 16);
        const float rstd = __builtin_amdgcn_rsqf(v * (1.0f / 256.0f) + 1e-6f);
#pragma unroll
        for (int j = 0; j < 8; ++j) x[j] = x[j] * rstd * lg[j] + lb[j];
        v4u o; o.x = pkbf(x[0], x[1]); o.y = pkbf(x[2], x[3]); o.z = pkbf(x[4], x[5]); o.w = pkbf(x[6], x[7]);
        *(LAS v4u*)(img + tl * 512 + ((2 * c0) ^ img_swz(tl))) = o; }
}
__device__ __forceinline__ void unpack8(const v4u& w, f32x4& a, f32x4& b) { a[0] = bf_lo(w.x); a[1] = bf_hi(w.x); a[2] = bf_lo(w.y); a[3] = bf_hi(w.y); b[0] = bf_lo(w.z); b[1] = bf_hi(w.z); b[2] = bf_lo(w.w); b[3] = bf_hi(w.w); }
__device__ __forceinline__ void gmlp_compute(Frame& F, LAS const unsigned char* img, const bf16x8 (&bw)[4][4], int l, int b, int chunk) {
    const bf16* P = (const bf16*)(F.ws + WS_P); bf16* Y = (bf16*)(F.ws + WS_Y);
    const int tok0 = b * SEQ + 128 * chunk, w = F.wave, lane = F.lane, h = w >> 1, ph = w & 1, g = lane >> 4, r = lane & 15;
    f32x4 acc[4][4];
    spatial_core<4>(img, bw, 64 * h, lane, acc);
    v4u uu[4][2], gg[4][2];
#pragma unroll
    for (int nt = 0; nt < 4; ++nt) { const size_t tok = (size_t)(tok0 + 64 * ph + 16 * nt + r);
#pragma unroll
        for (int t = 0; t < 2; ++t) { uu[nt][t] = *(const GAS v4u*)(pplane(P, S_AU, h) + tok * 64 + 32 * t + 8 * g); gg[nt][t] = *(const GAS v4u*)(pplane(P, S_AG, h) + tok * 64 + 32 * t + 8 * g); } }
    __builtin_amdgcn_sched_barrier(0);
#pragma unroll
    for (int nt = 0; nt < 4; ++nt) { const int p = 64 * ph + 16 * nt + r; const size_t tok = (size_t)(tok0 + p); const float bs = F.in[I_BS][(l * 4 + h) * 128 + p];
#pragma unroll
        for (int t = 0; t < 2; ++t) { const int ch = 64 * h + 32 * t + 8 * g; f32x4 u0, u1, g0, g1; unpack8(uu[nt][t], u0, u1); unpack8(gg[nt][t], g0, g1);
            store8bf(Y + tok * DM + ch, u0 * (acc[2 * t][nt] + bs) * silu4(g0), u1 * (acc[2 * t + 1][nt] + bs) * silu4(g1)); } }
}
__device__ __forceinline__ void fft1_compute(Frame& F, LAS const unsigned char* img, const bf16x8 (&bw)[4][4], int b, int s2) {
    bf16* T = (bf16*)(F.ws + WS_T);
    const int w = F.wave, lane = F.lane, cs = w >> 1, kh = w & 1, g = lane >> 4, r = lane & 15;
    f32x4 acc[4][4];
    spatial_core<4>(img, bw, 64 * cs, lane, acc);
    const float* TW = (const float*)(F.ws + WS_TW);
#pragma unroll
    for (int a = 0; a < 2; ++a) { const int k1 = 32 * kh + 16 * a + r; const float ct = TW[2 * (s2 * 64 + k1)], st = TW[2 * (s2 * 64 + k1) + 1];
        bf16* tr_ = T + ((size_t)((b * 64 + k1) * 2 + 0) * 64 + s2) * 256; bf16* ti_ = tr_ + (size_t)64 * 256;
#pragma unroll
        for (int mt = 0; mt < 4; ++mt) { const int ch = 64 * cs + 32 * (mt >> 1) + 8 * g + 4 * (mt & 1); const f32x4 Ar = acc[mt][a], Ai = acc[mt][a + 2];
            store4bf(tr_ + ch, Ar[0] * ct + Ai[0] * st, Ar[1] * ct + Ai[1] * st, Ar[2] * ct + Ai[2] * st, Ar[3] * ct + Ai[3] * st);
            store4bf(ti_ + ch, Ai[0] * ct - Ar[0] * st, Ai[1] * ct - Ar[1] * st, Ai[2] * ct - Ar[2] * st, Ai[3] * ct - Ar[3] * st); } }
}
__device__ __forceinline__ void fft2_compute(Frame& F, LAS const unsigned char* img, const bf16x8 (&bw)[4][2], int b, int k1) {
    const bf16* P = (const bf16*)(F.ws + WS_P); bf16* Y = (bf16*)(F.ws + WS_Y);
    const int w = F.wave, lane = F.lane, cs = w >> 1, k2h = w & 1, g = lane >> 4, r = lane & 15;
    f32x4 gt[2][2][2];
#pragma unroll
    for (int nt = 0; nt < 2; ++nt) { const size_t tok = (size_t)(b * SEQ + 64 * (32 * k2h + 16 * nt + r) + k1);
#pragma unroll
        for (int t = 0; t < 2; ++t) load8bf(pplane(P, S_CG, cs) + tok * 64 + 32 * t + 8 * g, gt[nt][t][0], gt[nt][t][1]); }
    f32x4 acc[4][2];
    spatial_core<2>(img, bw, 64 * cs, lane, acc);
#pragma unroll
    for (int nt = 0; nt < 2; ++nt) { const size_t tok = (size_t)(b * SEQ + 64 * (32 * k2h + 16 * nt + r) + k1);
#pragma unroll
        for (int t = 0; t < 2; ++t) store8bf(Y + tok * DM + 512 + 64 * cs + 32 * t + 8 * g, acc[2 * t][nt] * silu4(gt[nt][t][0]), acc[2 * t + 1][nt] * silu4(gt[nt][t][1])); }
}
__device__ __forceinline__ void spatial_seq(Frame& F, int l, int u) {
    FRESH_LANES(F);
    const int b = u >> 5, chunk = u & 31, s2a = 2 * (u & 31), w = F.wave;
    const bf16* P = (const bf16*)(F.ws + WS_P);
    LAS unsigned char* img0 = F.lds; LAS unsigned char* img1 = F.lds + IMG_BYTES;

#ifdef SPAN_SS
    if (l == 0 && F.tid == 0) F.MISC[16 + 0] = (unsigned)__builtin_amdgcn_s_memrealtime();
#endif
    ImgRegs R;
    gmlp_issue(F, R, b, chunk);
    bf16x8 bw[4][4];
    { const int h = w >> 1, ph = w & 1; const int arow[4] = {h * 128 + 64 * ph, h * 128 + 64 * ph + 16, h * 128 + 64 * ph + 32, h * 128 + 64 * ph + 48};
      LOAD_BW(bw, 4, (const bf16*)(F.ws + WS_WS) + (size_t)l * 4 * 128 * 128, arow); }
    gmlp_commit(F, R, img0, l);
    __syncthreads();
#ifdef SPAN_SS
    if (l == 0 && F.tid == 0) F.MISC[16 + 1] = (unsigned)__builtin_amdgcn_s_memrealtime();
#endif

    IMG_ISSUE(R, ptok(P, kk < 64 ? S_XC : S_XS) + (size_t)(b * SEQ + 64 * (kk & 63) + s2a) * 256);
    gmlp_compute(F, img0, bw, l, b, chunk);
#ifdef SPAN_SS
    if (l == 0 && F.tid == 0) F.MISC[16 + 2] = (unsigned)__builtin_amdgcn_s_memrealtime();
#endif

    { const int kh = w & 1; const int arow[4] = {32 * kh, 32 * kh + 16, 64 + 32 * kh, 64 + 32 * kh + 16};
      LOAD_BW(bw, 4, (const bf16*)(F.ws + WS_F1), arow); }
    IMG_COMMIT(R, img1);
    __syncthreads();
#ifdef SPAN_SS
    if (l == 0 && F.tid == 0) F.MISC[16 + 3] = (unsigned)__builtin_amdgcn_s_memrealtime();
#endif

    IMG_ISSUE(R, ptok(P, kk < 64 ? S_XC : S_XS) + (size_t)(b * SEQ + 64 * (kk & 63) + s2a + 1) * 256);
    fft1_compute(F, img1, bw, b, s2a);
#ifdef SPAN_SS
    if (l == 0 && F.tid == 0) F.MISC[16 + 4] = (unsigned)__builtin_amdgcn_s_memrealtime();
#endif

    IMG_COMMIT(R, img0);
    __syncthreads();
#ifdef SPAN_SS
    if (l == 0 && F.tid == 0) F.MISC[16 + 5] = (unsigned)__builtin_amdgcn_s_memrealtime();
#endif

    fft1_compute(F, img0, bw, b, s2a + 1);
    __syncthreads();
#ifdef SPAN_SS
    if (l == 0 && F.tid == 0) F.MISC[16 + 6] = (unsigned)__builtin_amdgcn_s_memrealtime();
#endif

}
__device__ __forceinline__ void fft2_seq(Frame& F, int u) {
    FRESH_LANES(F);
    const int b = u >> 5, k1a = 2 * (u & 31), w = F.wave;
    const bf16* T = (const bf16*)(F.ws + WS_T);
    LAS unsigned char* img0 = F.lds; LAS unsigned char* img1 = F.lds + IMG_BYTES;
    ImgRegs R0, R1;
    IMG_ISSUE(R0, T + ((size_t)(b * 64 + k1a) * 128 + kk) * 256);
    IMG_ISSUE(R1, T + ((size_t)(b * 64 + k1a + 1) * 128 + kk) * 256);
    bf16x8 bw[4][2];
    { const int k2h = w & 1; const int arow[2] = {32 * k2h, 32 * k2h + 16}; LOAD_BW(bw, 2, (const bf16*)(F.ws + WS_F2), arow); }
    IMG_COMMIT(R0, img0); IMG_COMMIT(R1, img1);
    __syncthreads();
    fft2_compute(F, img0, bw, b, k1a);
    fft2_compute(F, img1, bw, b, k1a + 1);
    __syncthreads();
}

__device__ __forceinline__ int att_f(int row) { return ((row >> 1) & 1) | (((row >> 3) & 1) << 1); }
#define ATT_SB() __builtin_amdgcn_sched_barrier(0)
#define ATT_KLOAD(DST, GRP) do { _Pragma("unroll") for (int t_ = 0; t_ < 4; ++t_) { const int kb_ = (RBK_(2 * (GRP) + (t_ >> 1))) * 128 + klo_[t_ & 1]; \
        (DST)[t_][0] = *(const LAS bf16x8*)(kimg_ + kb_); (DST)[t_][1] = *(const LAS bf16x8*)(kimg_ + (kb_ ^ 64)); } } while (0)
#define ATT_QKMMA(SRC, GRP) do { _Pragma("unroll") for (int t_ = 0; t_ < 4; ++t_) s_[4 * (GRP) + t_] = __builtin_amdgcn_mfma_f32_16x16x32_bf16((SRC)[t_][0], qf0_, negb_, 0, 0, 0); \
        _Pragma("unroll") for (int t_ = 0; t_ < 4; ++t_) s_[4 * (GRP) + t_] = __builtin_amdgcn_mfma_f32_16x16x32_bf16((SRC)[t_][1], qf1_, s_[4 * (GRP) + t_], 0, 0, 0); } while (0)
#define ATT_VLOAD(DST, KK) do { const int vb_ = (RBK_(KK)) * 128; _Pragma("unroll") for (int dt_ = 0; dt_ < 4; ++dt_) { (DST)[dt_][0] = tr_read(vimg_ + vb_ + vlo_[dt_]); (DST)[dt_][1] = tr_read(vimg_ + vb_ + vlo_[dt_] + 512); } } while (0)
#define ATT_PVMMA(SRC, KK) do { v4u pw_; pw_.x = pkbf(s_[2 * (KK)][0], s_[2 * (KK)][1]); pw_.y = pkbf(s_[2 * (KK)][2], s_[2 * (KK)][3]); pw_.z = pkbf(s_[2 * (KK) + 1][0], s_[2 * (KK) + 1][1]); pw_.w = pkbf(s_[2 * (KK) + 1][2], s_[2 * (KK) + 1][3]); \
        const bf16x8 pf_ = __builtin_bit_cast(bf16x8, pw_); \
        _Pragma("unroll") for (int dt_ = 0; dt_ < 4; ++dt_) { const bf16x8 vf_ = (bf16x8){(SRC)[dt_][0][0], (SRC)[dt_][0][1], (SRC)[dt_][0][2], (SRC)[dt_][0][3], (SRC)[dt_][1][0], (SRC)[dt_][1][1], (SRC)[dt_][1][2], (SRC)[dt_][1][3]}; \
            (O_)[dt_] = __builtin_amdgcn_mfma_f32_16x16x32_bf16(vf_, pf_, (O_)[dt_], 0, 0, 0); } \
        osum_ = __builtin_amdgcn_mfma_f32_16x16x32_bf16(ones_, pf_, osum_, 0, 0, 0); } while (0)
#define ATT_CORE_QK(KIMG, VIMG, FIXGRP, QF, NEGB) \
    const int g_ = lane >> 4, r_ = lane & 15, q_ = r_ >> 2, p_ = r_ & 3; \
    LAS const unsigned char* const kimg_ = (KIMG); LAS const unsigned char* const vimg_ = (VIMG); \
    const bf16x8 qf0_ = (QF)[0], qf1_ = (QF)[1]; const f32x4 negb_ = (f32x4){(NEGB), (NEGB), (NEGB), (NEGB)}; \
    int klo_[2], vlo_[4]; \
    { const int rb0_ = RBK_(0); \
      _Pragma("unroll") for (int hh = 0; hh < 2; ++hh) { const int Rl_ = 8 * (r_ >> 2) + 4 * hh + (r_ & 3); klo_[hh] = Rl_ * 128 + ((16 * g_) ^ (att_f(rb0_ + Rl_) << 5)); } \
      const int Rv_ = 8 * g_ + q_, f0_ = att_f(rb0_ + Rv_); \
      _Pragma("unroll") for (int dt = 0; dt < 4; ++dt) vlo_[dt] = Rv_ * 128 + 32 * (dt ^ f0_) + 8 * p_; } \
    f32x4 s_[16]; \
    { bf16x8 ka_[4][2], kb2_[4][2]; \
      ATT_KLOAD(ka_, 0); \
      ATT_KLOAD(kb2_, 1); ATT_SB(); ATT_QKMMA(ka_, 0); ATT_SB(); \
      ATT_KLOAD(ka_, 2);  ATT_SB(); ATT_QKMMA(kb2_, 1); FIXGRP(0); ATT_SB(); \
      ATT_KLOAD(kb2_, 3); ATT_SB(); ATT_QKMMA(ka_, 2); FIXGRP(1); ATT_SB(); \
      ATT_QKMMA(kb2_, 3); FIXGRP(2); FIXGRP(3); }
#define ATT_CORE_PV(O, LSUM) \
    f32x4 (&O_)[4] = (O); \
    s16x4 va_[4][2], vb2_[4][2]; \
    ATT_VLOAD(va_, 0); \
    _Pragma("unroll") for (int t = 0; t < 16; ++t) { _Pragma("unroll") for (int i = 0; i < 4; ++i) s_[t][i] = __builtin_amdgcn_exp2f(s_[t][i]); }     \
    const bf16x8 ones_ = (bf16x8){0x3F80, 0x3F80, 0x3F80, 0x3F80, 0x3F80, 0x3F80, 0x3F80, 0x3F80}; f32x4 osum_ = (f32x4){0.f, 0.f, 0.f, 0.f}; \
    _Pragma("unroll") for (int dt = 0; dt < 4; ++dt) O_[dt] = (f32x4){0.f, 0.f, 0.f, 0.f}; \
    ATT_VLOAD(vb2_, 1); ATT_SB(); ATT_PVMMA(va_, 0); ATT_SB(); \
    ATT_VLOAD(va_, 2);  ATT_SB(); ATT_PVMMA(vb2_, 1); ATT_SB(); \
    ATT_VLOAD(vb2_, 3); ATT_SB(); ATT_PVMMA(va_, 2); ATT_SB(); \
    ATT_VLOAD(va_, 4);  ATT_SB(); ATT_PVMMA(vb2_, 3); ATT_SB(); \
    ATT_VLOAD(vb2_, 5); ATT_SB(); ATT_PVMMA(va_, 4); ATT_SB(); \
    ATT_VLOAD(va_, 6);  ATT_SB(); ATT_PVMMA(vb2_, 5); ATT_SB(); \
    ATT_VLOAD(vb2_, 7); ATT_SB(); ATT_PVMMA(va_, 6); ATT_SB(); \
    ATT_PVMMA(vb2_, 7); (LSUM) = osum_[0];
#define ATT_CORE(KIMG, VIMG, FIXGRP, QF, NEGB, O, LSUM) do { ATT_CORE_QK(KIMG, VIMG, FIXGRP, QF, NEGB) ATT_CORE_PV(O, LSUM) } while (0)

__device__ __forceinline__ float att_qnorm(const bf16x8 (&qf)[2]) {
    float ss = 0.f;
#pragma unroll
    for (int k = 0; k < 2; ++k) { const v4u w = __builtin_bit_cast(v4u, qf[k]);
        const float a0 = bf_lo(w.x), a1 = bf_hi(w.x), a2 = bf_lo(w.y), a3 = bf_hi(w.y), a4 = bf_lo(w.z), a5 = bf_hi(w.z), a6 = bf_lo(w.w), a7 = bf_hi(w.w);
        ss += ((a0 * a0 + a1 * a1) + (a2 * a2 + a3 * a3)) + ((a4 * a4 + a5 * a5) + (a6 * a6 + a7 * a7)); }
    ss = pg8::red_add_g4(ss);
    return sqrtf(ss);
}
struct GateRegs { u32x2v w[4]; };
__device__ __forceinline__ void att_load_gate(const bf16* gate_row, int g, GateRegs& gt) {
#pragma unroll
    for (int dt = 0; dt < 4; ++dt) gt.w[dt] = *(const GAS u32x2v*)(gate_row + 16 * dt + 4 * g);
}
__device__ __forceinline__ void att_epilogue(const f32x4 (&o)[4], float lsum, const GateRegs& gt, bf16* y_row, int g) {
    const float inv = __builtin_amdgcn_rcpf(lsum);
    unsigned w[4][2];
#pragma unroll
    for (int dt = 0; dt < 4; ++dt) { const float g0 = bf_lo(gt.w[dt].x), g1 = bf_hi(gt.w[dt].x), g2 = bf_lo(gt.w[dt].y), g3 = bf_hi(gt.w[dt].y);
        w[dt][0] = pkbf(o[dt][0] * inv * silu_f(g0), o[dt][1] * inv * silu_f(g1)); w[dt][1] = pkbf(o[dt][2] * inv * silu_f(g2), o[dt][3] * inv * silu_f(g3)); }
#pragma unroll
    for (int pr = 0; pr < 2; ++pr) { const int A = 2 * pr, B = 2 * pr + 1;
        const auto s0 = __builtin_amdgcn_permlane16_swap(w[A][0], w[B][0], false, false); const auto s1 = __builtin_amdgcn_permlane16_swap(w[A][1], w[B][1], false, false);
        v4u ov; ov.x = s0[0]; ov.y = s1[0]; ov.z = s0[1]; ov.w = s1[1];
        *(GAS v4u*)(y_row + 16 * ((g & 1) ? B : A) + 8 * (g >> 1)) = ov; }
}

__device__ __forceinline__ int na_base(int rp) { int rs = 2 * rp - 4; rs = rs < 0 ? 0 : (rs > 56 ? 56 : rs); return rs < 55 ? rs : 55; }
template <int NRP>
__device__ __forceinline__ void natten_seq(Frame& F, int l, int b, int h, int rp0) {
    FRESH_LANES(F);
    const bf16* P = (const bf16*)(F.ws + WS_P); bf16* Y = (bf16*)(F.ws + WS_Y);
    const int w = F.wave, lane = F.lane, tid = F.tid;
    LAS unsigned char* Kimg = F.lds + ATT_K_OFF; LAS unsigned char* Vimg = F.lds + ATT_V_OFF; LAS float* bt = (LAS float*)(F.lds + ATT_BT_OFF);
    const bf16* Pk = pplane(P, S_BK, h) + (size_t)(b * SEQ) * 64;
    constexpr size_t KV = 4 * PLANE;
    {
        const int base = na_base(rp0);
        v4u kv[9], vv[9];
#pragma unroll
        for (int j = 0; j < 9; ++j) { const int id = tid + 512 * j, key = id >> 3, c = id & 7; const bf16* src = Pk + (size_t)(base * 64 + key) * 64 + 8 * c; kv[j] = *(const GAS v4u*)src; vv[j] = *(const GAS v4u*)(src + KV); }
        if (tid < 15 * 32) { const int dr = tid >> 5, dc = tid & 31; bt[tid] = dc < 31 ? F.in[I_RPB][((l * 4 + h) * 15 + dr) * 31 + dc] * LOG2E : -1e30f; }
#pragma unroll
        for (int j = 0; j < 9; ++j) { const int id = tid + 512 * j, key = id >> 3, c = id & 7; const int arow = base + (key >> 6), col = key & 63;
            const int off = ((arow % 9) * 64 + col) * 128 + ((16 * c) ^ (att_f(col) << 5));
            *(LAS v4u*)(Kimg + off) = kv[j]; *(LAS v4u*)(Vimg + off) = vv[j]; }
    }
    const int g = lane >> 4, r = lane & 15, qg = w & 3;
    const int cb = (qg == 0) ? 0 : (qg == 1 ? 8 : (qg == 2 ? 24 : 32));
    const int cq = 16 * qg + r; int cs = cq - 8; cs = cs < 0 ? 0 : (cs > 48 ? 48 : cs);
    int bto[2][4];
#pragma unroll
    for (int hh = 0; hh < 2; ++hh)
#pragma unroll
        for (int i = 0; i < 4; ++i) { const int ck = cb + 8 * g + 4 * hh + i; bto[hh][i] = 4 * (((unsigned)(ck - cs) < 16u) ? (ck - cq + 15) : 31); }
    const float bnd_k = ((const float*)(F.ws + WS_BND))[8 * l + 0], bnd_b = ((const float*)(F.ws + WS_BND))[8 * l + 2 + h];
    int hi_loaded = na_base(rp0) + 9;
    bf16x8 qf[2]; GateRegs gt;
    { const size_t tok = (size_t)(b * SEQ + (2 * rp0 + (w >> 2)) * 64 + cq);
      qf[0] = *(const GAS bf16x8*)(pplane(P, S_BQ, h) + tok * 64 + 8 * g); qf[1] = *(const GAS bf16x8*)(pplane(P, S_BQ, h) + tok * 64 + 32 + 8 * g); }
#pragma unroll 1
    for (int j = 0; j < NRP; ++j) {
        const int rp = rp0 + j, qrow = 2 * rp + (w >> 2);
        const size_t tok = (size_t)(b * SEQ + qrow * 64 + cq);

#ifdef SPAN_NA
        if (l == 0 && j == 1 && F.tid == 0) F.MISC[24 + 0] = (unsigned)__builtin_amdgcn_s_memrealtime();
#endif
        att_load_gate(pplane(P, S_BG, h) + tok * 64, g, gt);
        __syncthreads();
        if (w >= 4) __builtin_amdgcn_s_sleep(10);
#ifdef SPAN_NA
        if (l == 0 && j == 1 && F.tid == 0) F.MISC[24 + 1] = (unsigned)__builtin_amdgcn_s_memrealtime();
#endif

        int rs = qrow - 4; rs = rs < 0 ? 0 : (rs > 56 ? 56 : rs);
        const int dr0 = rs - qrow + 7;
        f32x4 o[4]; float lsum;
        LAS const unsigned char* const btrow = (LAS const unsigned char*)bt + dr0 * 128;
        const float negb = -(att_qnorm(qf) * bnd_k + bnd_b);
        bf16x8 qn[2]; v4u pk[2], pv[2]; int nlo = 0, nnew = 0;
#define RBK_(KK) ((((rs + (KK)) % 9) * 64) + cb)
#define NA_FIXGRP(GRP) do { _Pragma("unroll") for (int t_ = 0; t_ < 4; ++t_) { _Pragma("unroll") for (int i = 0; i < 4; ++i) \
            s_[4 * (GRP) + t_][i] += *(const LAS float*)(btrow + (2 * (GRP) + (t_ >> 1)) * 128 + bto[t_ & 1][i]); } } while (0)
        {   ATT_CORE_QK(Kimg, Vimg, NA_FIXGRP, qf, negb)

#ifdef SPAN_NA
        if (l == 0 && j == 1 && F.tid == 0) F.MISC[24 + 2] = (unsigned)__builtin_amdgcn_s_memrealtime();
#endif
            if (j + 1 < NRP) { const size_t tn = tok + 128;
                qn[0] = *(const GAS bf16x8*)(pplane(P, S_BQ, h) + tn * 64 + 8 * g); qn[1] = *(const GAS bf16x8*)(pplane(P, S_BQ, h) + tn * 64 + 32 + 8 * g);
                const int nb = na_base(rp + 1); nlo = hi_loaded > nb ? hi_loaded : nb; nnew = nb + 9 - nlo;
#pragma unroll
                for (int t = 0; t < 2; ++t) { const int id = tid + 512 * t, ri = id >> 9, col = (id >> 3) & 63, c = id & 7;
                    if (ri < nnew) { const bf16* src = Pk + (size_t)((nlo + ri) * 64 + col) * 64 + 8 * c; pk[t] = *(const GAS v4u*)src; pv[t] = *(const GAS v4u*)(src + KV); } } }
            ATT_CORE_PV(o, lsum) }

#ifdef SPAN_NA
        if (l == 0 && j == 1 && F.tid == 0) F.MISC[24 + 3] = (unsigned)__builtin_amdgcn_s_memrealtime();
#endif
#undef NA_FIXGRP
#undef RBK_
        att_epilogue(o, lsum, gt, Y + tok * DM + 256 + 64 * h, g);
#ifdef SPAN_NA
        if (l == 0 && j == 1 && F.tid == 0) F.MISC[24 + 4] = (unsigned)__builtin_amdgcn_s_memrealtime();
#endif
        __syncthreads();
#ifdef SPAN_NA
        if (l == 0 && j == 1 && F.tid == 0) F.MISC[24 + 5] = (unsigned)__builtin_amdgcn_s_memrealtime();
#endif
        if (j + 1 < NRP) {
#pragma unroll
            for (int t = 0; t < 2; ++t) { const int id = tid + 512 * t, ri = id >> 9, col = (id >> 3) & 63, c = id & 7;
                if (ri < nnew) { const int off = (((nlo + ri) % 9) * 64 + col) * 128 + ((16 * c) ^ (att_f(col) << 5)); *(LAS v4u*)(Kimg + off) = pk[t]; *(LAS v4u*)(Vimg + off) = pv[t]; } }
            hi_loaded = nlo + nnew;
            qf[0] = qn[0]; qf[1] = qn[1]; }
#ifdef SPAN_NA
        if (l == 0 && j == 1 && F.tid == 0) F.MISC[24 + 6] = (unsigned)__builtin_amdgcn_s_memrealtime();
#endif
    }
}
__device__ __forceinline__ void memattn_unit(Frame& F, int l, int b, int h, int tb) {
    FRESH_LANES(F);
    const bf16* P = (const bf16*)(F.ws + WS_P); bf16* Y = (bf16*)(F.ws + WS_Y); const bf16* MKV = (const bf16*)(F.ws + WS_MKV);
    const int w = F.wave, lane = F.lane, tid = F.tid;
    LAS unsigned char* Kimg = F.lds + ATT_K_OFF; LAS unsigned char* Vimg = F.lds + ATT_V_OFF;
    const bf16* Mb = MKV + (size_t)(b * NMEM) * 1024 + l * 512 + 64 * h;
    const int g = lane >> 4, r = lane & 15;
    const size_t tok0 = (size_t)(b * SEQ + 512 * tb + 16 * w + r);
    const float bnd_k = ((const float*)(F.ws + WS_BND))[8 * l + 1];
    bf16x8 qf[2]; GateRegs gt;
    { v4u kv[4], vv[4];
#pragma unroll
      for (int j = 0; j < 4; ++j) { const int id = tid + 512 * j, key = id >> 3, c = id & 7; const bf16* src = Mb + (size_t)key * 1024 + 8 * c; kv[j] = *(const GAS v4u*)src; vv[j] = *(const GAS v4u*)(src + 256); }
      qf[0] = *(const GAS bf16x8*)(pplane(P, S_DQ, h) + tok0 * 64 + 8 * g); qf[1] = *(const GAS bf16x8*)(pplane(P, S_DQ, h) + tok0 * 64 + 32 + 8 * g);
      att_load_gate(pplane(P, S_DG, h) + tok0 * 64, g, gt);
#pragma unroll
      for (int j = 0; j < 4; ++j) { const int id = tid + 512 * j, key = id >> 3, c = id & 7; const int off = key * 128 + ((16 * c) ^ (att_f(key) << 5));
          *(LAS v4u*)(Kimg + off) = kv[j]; *(LAS v4u*)(Vimg + off) = vv[j]; } }
    __syncthreads();
#pragma unroll 1
    for (int rnd = 0; rnd < 4; ++rnd) {
        const size_t tok = tok0 + 128 * rnd;
        bf16x8 qn[2]; GateRegs gn;
        if (rnd < 3) { const size_t tn = tok + 128;
            qn[0] = *(const GAS bf16x8*)(pplane(P, S_DQ, h) + tn * 64 + 8 * g); qn[1] = *(const GAS bf16x8*)(pplane(P, S_DQ, h) + tn * 64 + 32 + 8 * g);
            att_load_gate(pplane(P, S_DG, h) + tn * 64, g, gn); }
        f32x4 o[4]; float lsum;
#define RBK_(KK) (32 * (KK))
#define MA_FIXGRP(GRP) do { } while (0)
        const float negb = -(att_qnorm(qf) * bnd_k);
        ATT_CORE(Kimg, Vimg, MA_FIXGRP, qf, negb, o, lsum);
#undef MA_FIXGRP
#undef RBK_
        att_epilogue(o, lsum, gt, Y + tok * DM + 768 + 64 * h, g);
        if (rnd < 3) { qf[0] = qn[0]; qf[1] = qn[1]; gt = gn; }
    }
    __syncthreads();
}

constexpr int MKL_A_BYTES = 64 * 256, MKL_STAGE = MKL_A_BYTES + 128 * 256;
__device__ __forceinline__ void memkv_light(Frame& F) {
    FRESH_LANES(F);
    const bf16* memA = (const bf16*)(F.ws + WS_MEMA); const bf16* W = (const bf16*)(F.ws + WS_WMKV); bf16* MKV = (bf16*)(F.ws + WS_MKV);
    const int lane = F.lane, tid = F.tid, g = lane >> 4, r = lane & 15, tg = F.wave & 3, hd = F.wave >> 2;
    for (int u = F.vcu; u < 256; u += F.G) {
        const int b = u >> 5, tq = (u & 31) >> 3, nq = u & 7, rowt = b * NMEM + 64 * tq, nt0 = 128 * nq;
        v4u RA[6], RB[6];
#define MKL_ISSUE(R, C) do { _Pragma("unroll") for (int j = 0; j < 6; ++j) { const int id = tid + 512 * j; \
            if (j < 2) (R)[j] = *(const GAS v4u*)(memA + (size_t)(rowt + (id >> 4)) * 1024 + 128 * (C) + 8 * (id & 15)); \
            else { const int i2 = id - 1024; (R)[j] = *(const GAS v4u*)(W + (size_t)(nt0 + (i2 >> 4)) * 1024 + 128 * (C) + 8 * (i2 & 15)); } } } while (0)
#define MKL_COMMIT(R, ST) do { LAS unsigned char* sa_ = F.lds + (ST) * MKL_STAGE; _Pragma("unroll") for (int j = 0; j < 6; ++j) { const int id = tid + 512 * j; \
            if (j < 2) { const int row = id >> 4, ch = id & 15; *(LAS v4u*)(sa_ + row * 256 + ((ch ^ (row & 15)) << 4)) = (R)[j]; } \
            else { const int i2 = id - 1024, row = i2 >> 4, ch = i2 & 15; *(LAS v4u*)(sa_ + MKL_A_BYTES + row * 256 + ((ch ^ (row & 15)) << 4)) = (R)[j]; } } } while (0)
#define MKL_COMPUTE(ST) do { LAS const unsigned char* sa = F.lds + (ST) * MKL_STAGE; const int arow = 16 * tg + r; \
            _Pragma("unroll") for (int ks = 0; ks < 4; ++ks) { const bf16x8 af = *(const LAS bf16x8*)(sa + arow * 256 + (((4 * ks + g) ^ r) << 4)); \
                _Pragma("unroll") for (int mt = 0; mt < 4; ++mt) { const int wrow = 64 * hd + 16 * mt + r; \
                    const bf16x8 wf = *(const LAS bf16x8*)(sa + MKL_A_BYTES + wrow * 256 + (((4 * ks + g) ^ r) << 4)); \
                    acc[mt] = __builtin_amdgcn_mfma_f32_16x16x32_bf16(wf, af, acc[mt], 0, 0, 0); } } } while (0)
        f32x4 acc[4];
#pragma unroll
        for (int mt = 0; mt < 4; ++mt) acc[mt] = (f32x4){0.f, 0.f, 0.f, 0.f};
        MKL_ISSUE(RA, 0); MKL_ISSUE(RB, 1); MKL_COMMIT(RA, 0);
        __syncthreads();
#pragma unroll 1
        for (int c2 = 0; c2 < 8; c2 += 2) {
            if (c2 + 2 < 8) MKL_ISSUE(RA, c2 + 2);
            MKL_COMPUTE(0);
            MKL_COMMIT(RB, 1);
            __syncthreads();
            if (c2 + 3 < 8) MKL_ISSUE(RB, c2 + 3);
            MKL_COMPUTE(1);
            if (c2 + 2 < 8) MKL_COMMIT(RA, 0);
            __syncthreads();
        }
#undef MKL_COMPUTE
#undef MKL_ISSUE
#undef MKL_COMMIT
        const int row0 = rowt + 16 * tg, n0 = nt0 + 64 * hd;
        const int l = n0 >> 9; const bool isk = (n0 & 256) == 0;
        float hr = 1.0f;
        if (isk) { float ss = 0.f;
#pragma unroll
            for (int mt = 0; mt < 4; ++mt) ss += (acc[mt][0] * acc[mt][0] + acc[mt][1] * acc[mt][1]) + (acc[mt][2] * acc[mt][2] + acc[mt][3] * acc[mt][3]);
            ss = pg8::red_add_g4(ss); hr = __builtin_amdgcn_rsqf(ss * (1.0f / 64.0f) + 1e-6f); }
#pragma unroll
        for (int mt = 0; mt < 4; ++mt) { f32x4 v = acc[mt] * hr;
            if (isk) { const f32x4 gn = *(const GAS f32x4*)(F.in[I_MK] + 64 * l + 16 * mt + 4 * g); v = v * gn; }
            store4bf(MKV + (size_t)(row0 + r) * 1024 + n0 + 16 * mt + 4 * g, v[0], v[1], v[2], v[3]); }
    }
}

constexpr int CW_GB = 8192;
#define GB_SUB(j) (CW_GB + 64 * (j))
#define GB_GEN(j) (CW_GB + 64 * (16 + (j)))
__device__ __forceinline__ void group_barrier(unsigned* ctl, unsigned x, unsigned* tmo) {
    asm volatile("s_waitcnt vmcnt(0)" ::: "memory");
    __syncthreads();
    if (threadIdx.x == 0) {
        const unsigned old = xb_add(&ctl[GB_SUB(x)], 1u);
        const unsigned gen = old >> 5;
        if ((old & 31u) == 31u) {
            __builtin_amdgcn_fence(__ATOMIC_ACQUIRE, "agent");
            xb_add(&ctl[GB_GEN(x)], 1u);
            asm volatile("s_waitcnt vmcnt(0)" ::: "memory");
        } else {
            XB_SPIN(xb_ld(&ctl[GB_GEN(x)]) == gen, tmo - XB_TMO);
            __builtin_amdgcn_fence(__ATOMIC_ACQUIRE, "agent");
            asm volatile("s_waitcnt vmcnt(0)" ::: "memory");
        }
    }
    __syncthreads();
}

#define GB_FLAG(j) (CW_GB + 64 * (32 + (j)))
__device__ __forceinline__ void seam_arrive(unsigned* ctl, unsigned g, bool fast) {
    asm volatile("s_waitcnt vmcnt(0)" ::: "memory");
    __syncthreads();
    if (threadIdx.x == 0) {
        if (!fast) { __builtin_amdgcn_fence(__ATOMIC_RELEASE, "agent"); asm volatile("s_waitcnt vmcnt(0)" ::: "memory"); }
        xb_add(&ctl[GB_FLAG(fast ? g : 0u)], 1u);
    }
}
__device__ __forceinline__ void seam_wait(unsigned* ctl, unsigned g, bool fast, unsigned target, unsigned* tmo) {
    if (threadIdx.x == 0) {
        XB_SPIN(xb_ld(&ctl[GB_FLAG(fast ? g : 0u)]) < target, tmo - XB_TMO);
        __builtin_amdgcn_fence(__ATOMIC_ACQUIRE, "agent");
        asm volatile("s_waitcnt vmcnt(0)" ::: "memory");
    }
    __syncthreads();
}

#ifndef REP_PRO
#define REP_PRO 1
#endif
#ifndef REP_IN
#define REP_IN 1
#endif
#ifndef REP_MIX
#define REP_MIX 1
#endif
#ifndef REP_FFT2
#define REP_FFT2 1
#endif
#ifndef REP_OUT
#define REP_OUT 1
#endif
#ifndef REP_GMLP
#define REP_GMLP 1
#endif
#ifndef REP_FFT1
#define REP_FFT1 1
#endif
#ifndef REP_NAT
#define REP_NAT 1
#endif
#ifndef REP_MEMA
#define REP_MEMA 1
#endif
constexpr int N_PHASES = 7;
struct Args { const float* in[17]; float* out; unsigned char* ws; int ph_lo, ph_hi; };
__global__ void __launch_bounds__(NWAVES * 64, 2) mk_fwd(Args args) {
    extern __shared__ __attribute__((aligned(16))) unsigned char lds[];
    Frame F;
    F.lds = (LAS unsigned char*)lds;
    F.MISC = (volatile LAS unsigned*)(F.lds + MISC_OFF);
    F.tid = threadIdx.x; F.lane = F.tid & 63; F.wave = __builtin_amdgcn_readfirstlane(F.tid >> 6);
    F.G = gridDim.x; { const int bx = blockIdx.x; F.vcu = (F.G % 8 == 0) ? (bx % 8) * (F.G / 8) + bx / 8 : bx; }
    F.ws = args.ws; F.out = args.out; F.ctl = (gu32*)(args.ws + WS_CTL);
    F.in = (kargtab)__builtin_amdgcn_kernarg_segment_ptr();
    for (int u = F.tid; u < (LDS_BYTES - LDSCTL_OFF) / 4; u += NWAVES * 64) ((LAS unsigned*)(F.lds + LDSCTL_OFF))[u] = 0u;
    __syncthreads();
    const int lo = args.ph_lo, hi = args.ph_hi;
    const bool one_launch = (hi - lo) > 1;
    XcdBarrier bar; bar.bar = (unsigned*)(F.ctl + CW_BAR); bar.x = 0; bar.st = nullptr;
    if (one_launch) {
        bar.bar = (unsigned*)(F.ctl + CW_BAR); bar.x = xb_xcc_id(); bar.st = F.MISC + 8;
        if (F.tid == 0) F.MISC[10] = xb_add(&bar.bar[XB_XCNT(bar.x)], 1u);
    }
    bool fast = false; int cidx = (int)blockIdx.x;


#ifdef SPAN_PHASE
#ifndef SPAN_FROM
#define SPAN_FROM SPAN_PHASE
#endif
#endif
    for (int ph = lo; ph < hi; ++ph) {
#ifdef SPAN_PHASE
      if (ph == SPAN_FROM && F.tid == 0) F.MISC[20] = (unsigned)__builtin_amdgcn_s_memrealtime();
#endif
      const int reps_ = (ph == 0) ? REP_PRO : (((ph - 1) % 3) == 0 ? REP_IN : (((ph - 1) % 3) == 1 ? REP_MIX : (ph == 6 ? REP_OUT : 1)));
      for (int rep_ = 0; rep_ < reps_; ++rep_) {
        if (ph == 0) {
#ifndef NO_PRO
 p0_prologue(F);
#endif
 __syncthreads(); }
        else {
            const int l = (ph - 1) / 3, k = (ph - 1) % 3;
            FRESH_BASES(F);
            bf16* WinT = (bf16*)(F.ws + WS_WIN); bf16* WoutT = (bf16*)(F.ws + WS_WOUT);
            bf16* XB = (bf16*)(F.ws + WS_XB); bf16* PB = (bf16*)(F.ws + WS_P); bf16* YB = (bf16*)(F.ws + WS_Y); float* PART = (float*)(F.ws + WS_PART);
            if (k == 0) {
                if (l == 0) memkv_light(F);
                {
                    pg8::Gemm g{XB, WinT + (size_t)l * NPROJ * 1024, MTOK, NPROJ, 1024};
                    pg8::EpiProj E{PB, MTOK, S_XC, S_XS, PART, F.in[I_NAQ] + 64 * l, F.in[I_NAK] + 64 * l, F.in[I_MQ] + 64 * l, S_BQ, S_BK, S_DQ, QSCALE, 1.f, QSCALE};
                    pg8::StaticOrder S; S.init(MTOK, NPROJ, F.G, cidx);
#ifndef NO_G1
                    pg8::gemm_phase<pg8::EpiProj, pg8::StaticOrder, true, true>(F.lds, g, S, E, F.wave);
#endif
                }
            } else if (k == 1) {
#ifdef SPAN_MIX
                if (l == 0 && F.tid == 0) F.MISC[24 + 0] = (unsigned)__builtin_amdgcn_s_memrealtime();
#endif
#ifndef NO_GMLP
                for (int q_ = 0; q_ < REP_GMLP; ++q_) for (int u = F.vcu; u < 256; u += F.G) spatial_seq(F, l, u);
#endif
#ifdef SPAN_MIX
                if (l == 0 && F.tid == 0) F.MISC[24 + 1] = (unsigned)__builtin_amdgcn_s_memrealtime();
#endif
                seam_arrive((unsigned*)F.ctl, bar.x, fast);
#ifndef NO_NAT
                for (int q_ = 0; q_ < REP_NAT; ++q_) for (int u = F.vcu; u < 256; u += F.G) natten_seq<4>(F, l, u >> 5, (u & 31) >> 3, 4 * (u & 7));
#endif
#ifdef SPAN_MIX
                if (l == 0 && F.tid == 0) F.MISC[24 + 2] = (unsigned)__builtin_amdgcn_s_memrealtime();
#endif
#ifndef NO_MEMA
                for (int q_ = 0; q_ < REP_MEMA; ++q_) for (int u = F.vcu; u < 256; u += F.G) memattn_unit(F, l, u >> 5, (u & 31) >> 3, u & 7);
#endif
#ifdef SPAN_MIX
                if (l == 0 && F.tid == 0) F.MISC[24 + 3] = (unsigned)__builtin_amdgcn_s_memrealtime();
#endif
                seam_wait((unsigned*)F.ctl, bar.x, fast, (fast ? 32u : (unsigned)F.G) * (unsigned)((l + 1) * reps_), bar.bar + XB_TMO);
#ifdef SPAN_MIX
                if (l == 0 && F.tid == 0) F.MISC[24 + 4] = (unsigned)__builtin_amdgcn_s_memrealtime();
#endif
#ifndef NO_FFT2
                for (int u = F.vcu; u < 256; u += F.G) fft2_seq(F, u);
#endif
#ifdef SPAN_MIX
                if (l == 0 && F.tid == 0) F.MISC[24 + 5] = (unsigned)__builtin_amdgcn_s_memrealtime();
#endif
            } else {
                pg8::Gemm g{YB, WoutT + (size_t)l * 1024 * 1024, MTOK, DM, 1024};
                pg8::EpiOut E{XB, F.out, l == 0 ? XB : nullptr, PART, DM};
                pg8::StaticOrder S; S.init(MTOK, DM, F.G, cidx);
#ifndef NO_G2
                pg8::gemm_phase<pg8::EpiOut, pg8::StaticOrder, true, true>(F.lds, g, S, E, F.wave);
#endif
            }
        }
      }
#ifdef SPAN_PHASE
        if (ph == SPAN_PHASE) { __syncthreads(); if (F.tid == 0) F.MISC[21] = (unsigned)__builtin_amdgcn_s_memrealtime(); }
#endif
        if (ph + 1 < hi) {
            if (fast) group_barrier((unsigned*)F.ctl, bar.x, bar.bar + XB_TMO);
            else xcd_barrier(bar);
            if (one_launch && ph == lo) {
                if (F.tid == 0) { unsigned ok = (F.G == 256) ? 1u : 0u, rank = 0u, npop = 0u;
#pragma unroll
                    for (unsigned j = 0; j < 16; ++j) { const unsigned c = xb_ld(&bar.bar[XB_XCNT(j)]); if (c != 0u && c != 32u) ok = 0u; if (c) { ++npop; if (j < bar.x) ++rank; } }
                    if (npop != 8u) ok = 0u;
                    F.MISC[11] = ok; F.MISC[12] = rank; }
                __syncthreads();
                fast = __builtin_amdgcn_readfirstlane((int)F.MISC[11]) != 0;
                if (fast) { const int rank = __builtin_amdgcn_readfirstlane((int)F.MISC[12]), slot = __builtin_amdgcn_readfirstlane((int)F.MISC[10]); F.vcu = rank * 32 + slot; cidx = slot * 8 + rank; }
                __syncthreads();
            }
#if defined(SPAN_PHASE) && defined(SPAN_SEAM)
            if (ph == SPAN_PHASE && F.tid == 0) F.MISC[21] = (unsigned)__builtin_amdgcn_s_memrealtime();
#endif
        }
    }
#ifdef SPAN_PHASE
    xcd_barrier(bar);
#if defined(SPAN_MIX) || defined(SPAN_NA)
    if (blockIdx.x == SPAN_BLOCK && F.tid == 0) F.out[0] += 0.5f * rintf((float)(F.MISC[24 + SPAN_MIX_B] - F.MISC[24 + SPAN_MIX_A]) * 0.02f);
#elif defined(SPAN_SS)
    if (blockIdx.x == SPAN_BLOCK && F.tid == 0) F.out[0] += 2.0f * rintf((float)(F.MISC[16 + SPAN_SS_B] - F.MISC[16 + SPAN_SS_A]) * 0.005f);
#else
    if (blockIdx.x == SPAN_BLOCK && F.tid == 0) F.out[0] += 4.0f * rintf((float)(F.MISC[21] - F.MISC[20]) * 0.0025f);
#endif
#endif
}

#ifndef MK_N_LAUNCHES
#define MK_N_LAUNCHES 1
#endif
extern "C" void kernel_launch(void* const* d_in, const int* in_sizes, int n_in, void* d_out, int out_size, void* d_ws, size_t ws_size, hipStream_t stream) {
    static int grid = 0;
    if (grid == 0) {
        if (n_in != 17 || in_sizes[0] != MTOK * DM || out_size != MTOK * DM || ws_size < WS_END) { fprintf(stderr, "kernel_launch: unexpected shapes (n_in %d, in0 %d, out %d, ws %zu); nothing launched\n", n_in, n_in > 0 ? in_sizes[0] : -1, out_size, ws_size); grid = -1; return; }
        int dev = 0, cus = 0, per_cu = 0;
        if (hipGetDevice(&dev) != hipSuccess || hipDeviceGetAttribute(&cus, hipDeviceAttributeMultiprocessorCount, dev) != hipSuccess) { fprintf(stderr, "kernel_launch: device query failed\n"); grid = -1; return; }
        if (hipFuncSetAttribute((const void*)mk_fwd, hipFuncAttributeMaxDynamicSharedMemorySize, LDS_BYTES) != hipSuccess) { fprintf(stderr, "kernel_launch: hipFuncSetAttribute failed\n"); grid = -1; return; }
        if (hipOccupancyMaxActiveBlocksPerMultiprocessor(&per_cu, (const void*)mk_fwd, NWAVES * 64, LDS_BYTES) != hipSuccess || per_cu < 1)
            fprintf(stderr, "kernel_launch: note: occupancy query reports %d workgroups per CU\n", per_cu);
        (void)hipGetLastError();
        grid = cus;
    }
    if (grid < 0) return;
    if (hipMemsetAsync((char*)d_ws + WS_CTL, 0, CTL_ZERO_BYTES, stream) != hipSuccess) { fprintf(stderr, "kernel_launch: memset failed\n"); return; }
    Args a{};
    for (int i = 0; i < 17; ++i) a.in[i] = (const float*)d_in[i];
    a.out = (float*)d_out; a.ws = (unsigned char*)d_ws;
#if MK_N_LAUNCHES == 1
    a.ph_lo = 0; a.ph_hi = N_PHASES;
    hipLaunchKernelGGL(mk_fwd, dim3(grid), dim3(NWAVES * 64), LDS_BYTES, stream, a);
#else
    for (int ph = 0; ph < N_PHASES; ++ph) { a.ph_lo = ph; a.ph_hi = ph + 1; hipLaunchKernelGGL(mk_fwd, dim3(grid), dim3(NWAVES * 64), LDS_BYTES, stream, a); }
#endif
    const hipError_t le = hipPeekAtLastError();
    if (le != hipSuccess) fprintf(stderr, "kernel_launch: launch failed: %s\n", hipGetErrorName(le));
}
```

```cpp
#include <hip/hip_runtime.h>
#include <cstdio>
#include <cstdint>
#include <cmath>
namespace pg8 {
#define PG8_LAS __attribute__((address_space(3)))
typedef unsigned short bf16_t;
typedef short bf16x8 __attribute__((ext_vector_type(8)));
typedef float f32x4 __attribute__((ext_vector_type(4)));
typedef unsigned u32x4 __attribute__((ext_vector_type(4)));
constexpr int BM = 256, BK = 64, HALF = 128, HTB = HALF * BK * 2  , STAGE_BYTES = 8 * HTB, NXCD = 8, WGM = 8;

__host__ __device__ __forceinline__ int lds_byte(int r, int c) { const int st = (r >> 4) * 2 + (c >> 5), rr = r & 15, cc = c & 31, ob = rr * 64 + cc * 2; return st * 1024 + (ob ^ (((ob >> 9) & 1) << 5)); }
__host__ __device__ __forceinline__ void stage_rc(int b, int& R, int& C) { const int st = b / 1024, sb = b % 1024, swz = sb ^ (((sb >> 9) & 1) << 5); R = (st >> 1) * 16 + swz / 64; C = (st & 1) * 32 + (swz % 64) / 2; }
__host__ __device__ __forceinline__ int perm32(int rho) { const int n = rho >> 4, i = rho & 15; return 8 * (i >> 2) + 4 * n + (i & 3); }

struct Unit { int pm, pn; };
struct Gemm { const bf16_t* A; const bf16_t* Bt; int M, N, K; };

struct StaticOrder {
    int nM, nN, nwg, G, c, rot;
    __host__ __device__ void init(int M, int N, int G_, int c_, int rot_ = 0) { nM = M / BM; nN = N / BM; nwg = nM * nN; G = G_; c = c_; rot = rot_; }
    __host__ __device__ bool next(int i, Unit& u) const {
        const long L = (long)i * G + c; if (L >= nwg) return false;
        int wgid = (int)L; { const int q = nwg / NXCD, r = nwg % NXCD, xcd = wgid % NXCD, off = wgid / NXCD; wgid = (xcd < r ? xcd * (q + 1) : r * (q + 1) + (xcd - r) * q) + off; }
        const int nig = WGM * nN, gid = wgid / nig, fm = gid * WGM, gsz = (nM - fm) < WGM ? (nM - fm) : WGM;
        u.pm = fm + ((wgid % nig) % gsz); u.pn = (wgid % nig) / gsz; if (rot && (gid & 1)) u.pn = (u.pn & ~3) | ((u.pn + rot) & 3); return true;
    }
    __device__ __forceinline__ void a_ready(const Unit&) const {}
    __device__ __forceinline__ void done(const Unit&) const {}
};

__device__ __forceinline__ unsigned cvt_pk_bf16(float lo, float hi) { unsigned r; asm volatile("v_cvt_pk_bf16_f32 %0, %1, %2" : "=v"(r) : "v"(lo), "v"(hi)); return r; }
typedef float f32x2 __attribute__((ext_vector_type(2)));
#define SWZ_XOR(v, k) __uint_as_float((unsigned)__builtin_amdgcn_ds_swizzle((int)__float_as_uint(v), (((k) << 10) | 0x1F)))
__device__ __forceinline__ float red_add_x16(float v) { const auto r = __builtin_amdgcn_permlane16_swap(__float_as_uint(v), __float_as_uint(v), false, false); return __uint_as_float(r[0]) + __uint_as_float(r[1]); }
__device__ __forceinline__ float red_add_x32(float v) { const auto r = __builtin_amdgcn_permlane32_swap(__float_as_uint(v), __float_as_uint(v), false, false); return __uint_as_float(r[0]) + __uint_as_float(r[1]); }
__device__ __forceinline__ float red_max_x32(float v) { const auto r = __builtin_amdgcn_permlane32_swap(__float_as_uint(v), __float_as_uint(v), false, false); return fmaxf(__uint_as_float(r[0]), __uint_as_float(r[1])); }
__device__ __forceinline__ float red_add_g4(float v) { return red_add_x32(red_add_x16(v)); }
typedef unsigned u32x2 __attribute__((ext_vector_type(2)));
typedef __bf16 bf16x2v_t __attribute__((ext_vector_type(2)));
__device__ __forceinline__ unsigned cvt_pk_c(float lo, float hi) { const f32x2 v = {lo, hi}; return __builtin_bit_cast(unsigned, __builtin_convertvector(v, bf16x2v_t)); }
struct EpiProj {
    static constexpr bool PERM = true, AFTER_DRAIN = false;
    bf16_t* O; int ldc;
    int tm0, tm1;
    const float* part;
    const float* g0; const float* g1; const float* g2;
    int t0, t1, t2; float s0, s1, s2;
    unsigned gmask;
    const PG8_LAS float* rs_lds;
    const float* rs_src; PG8_LAS float* rs_dst;
    __device__ __forceinline__ void pre_issue(f32x4 (&p)[4]) const { if (rs_src) {
#pragma unroll
        for (int j = 0; j < 4; ++j) p[j] = *(const __attribute__((address_space(1))) f32x4*)(rs_src + 4 * j); } }
    __device__ __forceinline__ void pre_finish(const f32x4 (&p)[4]) const { if (rs_src) {
        const float t = (((p[0][0] + p[0][1]) + (p[0][2] + p[0][3])) + ((p[1][0] + p[1][1]) + (p[1][2] + p[1][3]))) + (((p[2][0] + p[2][1]) + (p[2][2] + p[2][3])) + ((p[3][0] + p[3][1]) + (p[3][2] + p[3][3])));
        *rs_dst = __builtin_amdgcn_rsqf(t * (1.0f / 1024.0f) + 1e-6f); } }
    __device__ __forceinline__ void operator()(const f32x4 (&acc)[2][2][4][2], const Unit& u, int wr, int wc, int fr, int fq) const {
        const float* gp = nullptr; float sc = 1.f;
        if (u.pn == t0) { gp = g0; sc = s0; } else if (u.pn == t1) { gp = g1; sc = s1; } else if (u.pn == t2) { gp = g2; sc = s2; }
        f32x4 gv[2][2];
#pragma unroll
        for (int bj = 0; bj < 2; ++bj)
#pragma unroll
            for (int n = 0; n < 2; ++n) gv[bj][n] = gp ? *(const f32x4*)(gp + 32 * bj + 8 * fq + 4 * n) : (f32x4){1.f, 1.f, 1.f, 1.f};
        const int row0 = u.pm * BM + wr * 64 + fr;
        f32x4 pv[2][4];
        float rsv[2][4];
        if (rs_lds) {
#pragma unroll
            for (int ai = 0; ai < 2; ++ai)
#pragma unroll
                for (int m = 0; m < 4; ++m) rsv[ai][m] = rs_lds[((u.pm >> 3) & 1) * 256 + wr * 64 + fr + ai * HALF + m * 16];
        } else if (part) {
#pragma unroll
            for (int ai = 0; ai < 2; ++ai)
#pragma unroll
                for (int m = 0; m < 4; ++m) pv[ai][m] = *(const f32x4*)(part + (size_t)(row0 + ai * HALF + m * 16) * 16 + 4 * fq);
        }
#pragma unroll
        for (int ai = 0; ai < 2; ++ai)
#pragma unroll
            for (int m = 0; m < 4; ++m) {
                const int row = row0 + ai * HALF + m * 16;
                float rs = 1.f;
                if (rs_lds) rs = rsv[ai][m];
                else if (part) { const f32x4 p4 = pv[ai][m]; float t = (p4[0] + p4[1]) + (p4[2] + p4[3]);
                    t = red_add_g4(t); rs = __builtin_amdgcn_rsqf(t * (1.0f / 1024.0f) + 1e-6f); }
                f32x4 v[2][2];
#pragma unroll
                for (int bj = 0; bj < 2; ++bj)
#pragma unroll
                    for (int n = 0; n < 2; ++n) v[bj][n] = acc[ai][bj][m][n] * rs;
                if (gp) {
                    float ss = 0.f;
#pragma unroll
                    for (int bj = 0; bj < 2; ++bj)
#pragma unroll
                        for (int n = 0; n < 2; ++n) { const f32x4 x = v[bj][n]; ss += (x[0] * x[0] + x[1] * x[1]) + (x[2] * x[2] + x[3] * x[3]); }
                    ss = red_add_g4(ss);
                    const float hr = sc * __builtin_amdgcn_rsqf(ss * (1.0f / 64.0f) + 1e-6f);
#pragma unroll
                    for (int bj = 0; bj < 2; ++bj)
#pragma unroll
                        for (int n = 0; n < 2; ++n) v[bj][n] = v[bj][n] * gv[bj][n] * hr;
                }
                if ((gmask >> u.pn) & 1u) {
#pragma unroll
                    for (int bj = 0; bj < 2; ++bj)
#pragma unroll
                        for (int n = 0; n < 2; ++n)
#pragma unroll
                            for (int i = 0; i < 4; ++i) { const float x = v[bj][n][i]; v[bj][n][i] = x * __builtin_amdgcn_rcpf(1.0f + __builtin_amdgcn_exp2f(-1.4426950408889634f * x)); }
                }
                const bool tokmajor = (u.pn == tm0) || (u.pn == tm1);
                bf16_t* rowp = tokmajor ? O + ((size_t)u.pn * ldc + row) * 256 + 64 * wc + 8 * fq
                                        : O + ((size_t)(u.pn * 4 + wc) * ldc + row) * 64 + 8 * fq;
#pragma unroll
                for (int bj = 0; bj < 2; ++bj) { u32x4 w; w.x = cvt_pk_c(v[bj][0][0], v[bj][0][1]); w.y = cvt_pk_c(v[bj][0][2], v[bj][0][3]); w.z = cvt_pk_c(v[bj][1][0], v[bj][1][1]); w.w = cvt_pk_c(v[bj][1][2], v[bj][1][3]);
                    *(u32x4*)(rowp + 32 * bj) = w; }
            }
    }
};
struct EpiOut {
    static constexpr bool PERM = true, AFTER_DRAIN = false;
    const bf16_t* base; float* out; bf16_t* xb; float* part; int ldc;
    __device__ __forceinline__ void pre_issue(f32x4 (&)[4]) const {}
    __device__ __forceinline__ void pre_finish(const f32x4 (&)[4]) const {}
    __device__ __forceinline__ void operator()(const f32x4 (&acc)[2][2][4][2], const Unit& u, int wr, int wc, int fr, int fq) const {
        const int col0 = u.pn * BM + wc * 32 + 8 * fq;
#pragma unroll
        for (int ai = 0; ai < 2; ++ai) {
            u32x4 bwa[4][2];
#pragma unroll
            for (int m = 0; m < 4; ++m)
#pragma unroll
                for (int bj = 0; bj < 2; ++bj) bwa[m][bj] = *(const u32x4*)(base + (size_t)(u.pm * BM + ai * HALF + wr * 64 + m * 16 + fr) * ldc + col0 + bj * HALF);
            __builtin_amdgcn_sched_barrier(0);
#pragma unroll
            for (int m = 0; m < 4; ++m) { const int row = u.pm * BM + ai * HALF + wr * 64 + m * 16 + fr; const size_t off = (size_t)row * ldc + col0; float ss = 0.f;
                const u32x4 (&bw)[2] = bwa[m];
#pragma unroll
                for (int bj = 0; bj < 2; ++bj) {
                    f32x4 o0, o1;
                    o0[0] = __uint_as_float(bw[bj].x << 16) + acc[ai][bj][m][0][0]; o0[1] = __uint_as_float(bw[bj].x & 0xffff0000u) + acc[ai][bj][m][0][1];
                    o0[2] = __uint_as_float(bw[bj].y << 16) + acc[ai][bj][m][0][2]; o0[3] = __uint_as_float(bw[bj].y & 0xffff0000u) + acc[ai][bj][m][0][3];
                    o1[0] = __uint_as_float(bw[bj].z << 16) + acc[ai][bj][m][1][0]; o1[1] = __uint_as_float(bw[bj].z & 0xffff0000u) + acc[ai][bj][m][1][1];
                    o1[2] = __uint_as_float(bw[bj].w << 16) + acc[ai][bj][m][1][2]; o1[3] = __uint_as_float(bw[bj].w & 0xffff0000u) + acc[ai][bj][m][1][3];
                    if (xb) { u32x4 w; w.x = cvt_pk_c(o0[0], o0[1]); w.y = cvt_pk_c(o0[2], o0[3]); w.z = cvt_pk_c(o1[0], o1[1]); w.w = cvt_pk_c(o1[2], o1[3]);
                        *(u32x4*)(xb + off + bj * HALF) = w;
                        ss += ((o0[0] * o0[0] + o0[1] * o0[1]) + (o0[2] * o0[2] + o0[3] * o0[3])) + ((o1[0] * o1[0] + o1[1] * o1[1]) + (o1[2] * o1[2] + o1[3] * o1[3])); }
                    else { *(f32x4*)(out + off + bj * HALF) = o0; *(f32x4*)(out + off + bj * HALF + 4) = o1; }
                }
                if (xb) { ss = red_add_g4(ss); if (fq == 0) part[(size_t)row * 16 + u.pn * 4 + wc] = ss; }
            }
        }
    }
};
template <class Epi, class Sched, bool ALIGN_EPI = false, bool SP2 = false>
__device__ __forceinline__ void gemm_phase(PG8_LAS unsigned char* lds, const Gemm g, const Sched& S, const Epi& E, int wave_id) {
    int tid_ = wave_id * 64 + (int)__builtin_amdgcn_mbcnt_hi(~0u, __builtin_amdgcn_mbcnt_lo(~0u, 0u)); asm volatile("" : "+v"(tid_));
    const int tid = tid_, wid = __builtin_amdgcn_readfirstlane(tid >> 6), lane = tid & 63, wr = wid >> 2, wc = wid & 3, fr = lane & 15, fq = lane >> 4;
    const int K = g.K, nt = K / BK;
    unsigned voffA[2], voffB[2];
#pragma unroll
    for (int i = 0; i < 2; ++i) { int R, C; stage_rc(tid * 16 + i * 8192, R, C); const int Rb = Epi::PERM ? ((R & ~31) + perm32(R & 31)) : R;
        voffA[i] = (unsigned)(R * K + C) * 2u; voffB[i] = (unsigned)(Rb * K + C) * 2u; }
    const size_t kstep = (size_t)(BK * 2);
    const size_t hstep = (size_t)HALF * K * 2;
    const size_t tstep = 2 * hstep;
    const unsigned ldsw = (unsigned)wid * 1024u;
    const int aoff = lds_byte(wr * 64 + fr, fq * 8), boff = lds_byte(wc * 32 + fr, fq * 8);
#define PG8_SA(b, h) (((b) * 2 + (h)) * HTB)
#define PG8_SB(b, h) ((4 + (b) * 2 + (h)) * HTB)
#define PG8_STAGE(bufoff, gbase, voff) do { _Pragma("unroll") for (int _i = 0; _i < 2; ++_i) \
        __builtin_amdgcn_global_load_lds((const unsigned*)((const char*)(gbase) + (voff)[_i]), (PG8_LAS unsigned*)(lds + (bufoff) + ldsw + _i * 8192), 16, 0, 0); } while (0)
#define PG8_LDA(dst, b, h) do { _Pragma("unroll") for (int m = 0; m < 4; ++m) _Pragma("unroll") for (int k = 0; k < 2; ++k) dst[m][k] = *(const PG8_LAS bf16x8*)(lds + PG8_SA(b, h) + aoff + m * 2048 + k * 1024); } while (0)
#define PG8_LDB(dst, b, h) do { _Pragma("unroll") for (int n = 0; n < 2; ++n) _Pragma("unroll") for (int k = 0; k < 2; ++k) dst[n][k] = *(const PG8_LAS bf16x8*)(lds + PG8_SB(b, h) + boff + n * 2048 + k * 1024); } while (0)
#define PG8_MMA(ai, bj, At, Bt) do { __builtin_amdgcn_s_setprio(1); _Pragma("unroll") for (int m = 0; m < 4; ++m) _Pragma("unroll") for (int n = 0; n < 2; ++n) _Pragma("unroll") for (int k = 0; k < 2; ++k) \
        acc[ai][bj][m][n] = __builtin_amdgcn_mfma_f32_16x16x32_bf16(Bt[n][k], At[m][k], acc[ai][bj][m][n], 0, 0, 0); __builtin_amdgcn_s_setprio(0); } while (0)
#define PG8_WAIT_V(n) asm volatile("s_waitcnt vmcnt(" #n ")" ::: "memory")
#define PG8_WAIT_L(n) asm volatile("s_waitcnt lgkmcnt(" #n ")" ::: "memory")
#define PG8_BAR __builtin_amdgcn_s_barrier()
#define PG8_SCHED __builtin_amdgcn_sched_barrier(0)
    Unit cur, nxt; int ui = 0;
    if (!S.next(0, cur)) return;
    f32x4 acc[2][2][4][2];
#pragma unroll
    for (int a = 0; a < 2; ++a)
#pragma unroll
        for (int b = 0; b < 2; ++b)
#pragma unroll
            for (int m = 0; m < 4; ++m)
#pragma unroll
                for (int n = 0; n < 2; ++n) acc[a][b][m][n] = (f32x4){0.f, 0.f, 0.f, 0.f};
    bf16x8 At[4][2], B0[2][2], B1[2][2];
    const char* cA = (const char*)g.A + (size_t)cur.pm * tstep; const char* cB = (const char*)g.Bt + (size_t)cur.pn * tstep;
    S.a_ready(cur);
    f32x4 pre_[4]; E.pre_issue(pre_);
    if constexpr (SP2) {
        PG8_STAGE(PG8_SB(0, 0), cB, voffB); PG8_STAGE(PG8_SB(0, 1), cB + hstep, voffB); PG8_STAGE(PG8_SA(0, 0), cA, voffA); PG8_STAGE(PG8_SA(0, 1), cA + hstep, voffA);
        if (wr == 1) PG8_BAR;
        PG8_WAIT_V(2); PG8_BAR;
        E.pre_finish(pre_);
        PG8_STAGE(PG8_SB(1, 0), cB + kstep, voffB); PG8_STAGE(PG8_SA(1, 0), cA + kstep, voffA); PG8_STAGE(PG8_SB(1, 1), cB + hstep + kstep, voffB);
        PG8_WAIT_V(6); PG8_BAR;
    } else {
        PG8_STAGE(PG8_SB(0, 0), cB, voffB); PG8_STAGE(PG8_SA(0, 0), cA, voffA); PG8_STAGE(PG8_SB(0, 1), cB + hstep, voffB); PG8_STAGE(PG8_SA(0, 1), cA + hstep, voffA);
        if (wr == 1) PG8_BAR;
        PG8_WAIT_V(4); PG8_BAR;
        PG8_STAGE(PG8_SB(1, 0), cB + kstep, voffB); PG8_STAGE(PG8_SA(1, 0), cA + kstep, voffA); PG8_STAGE(PG8_SB(1, 1), cB + hstep + kstep, voffB);
        PG8_WAIT_V(6); PG8_BAR;
    }
    for (;;) {
        const bool has_next = S.next(ui + 1, nxt);
        const char* nA = has_next ? (const char*)g.A + (size_t)nxt.pm * tstep : cA; const char* nB = has_next ? (const char*)g.Bt + (size_t)nxt.pn * tstep : cB;
        for (int t = 0; t < nt; t += 2) {
            const bool last = (t == nt - 2);
            const char* a1 = cA + (size_t)(t + 1) * kstep;
            const char* a2 = last ? nA : cA + (size_t)(t + 2) * kstep; const char* b2 = last ? nB : cB + (size_t)(t + 2) * kstep;
            const char* a3 = a2 + kstep; const char* b3 = b2 + kstep;
            if (last && has_next) S.a_ready(nxt);
            if constexpr (SP2) {
            PG8_LDB(B0, 0, 0); PG8_LDB(B1, 0, 1); PG8_SCHED; PG8_LDA(At, 0, 0); PG8_STAGE(PG8_SA(1, 1), a1 + hstep, voffA);
            PG8_WAIT_V(8); PG8_WAIT_L(0); PG8_BAR; PG8_MMA(0, 0, At, B0); PG8_MMA(0, 1, At, B1); PG8_BAR; PG8_SCHED;
            PG8_LDA(At, 0, 1); PG8_STAGE(PG8_SB(0, 0), b2, voffB); PG8_STAGE(PG8_SB(0, 1), b2 + hstep, voffB); PG8_STAGE(PG8_SA(0, 0), a2, voffA);
            PG8_WAIT_V(8); PG8_WAIT_L(0); PG8_BAR; PG8_MMA(1, 0, At, B0); PG8_MMA(1, 1, At, B1); PG8_BAR; PG8_SCHED;
            PG8_LDB(B0, 1, 0); PG8_LDB(B1, 1, 1); PG8_SCHED; PG8_LDA(At, 1, 0); PG8_STAGE(PG8_SA(0, 1), a2 + hstep, voffA);
            PG8_WAIT_V(8); PG8_WAIT_L(0); PG8_BAR; PG8_MMA(0, 0, At, B0); PG8_MMA(0, 1, At, B1); PG8_BAR; PG8_SCHED;
            PG8_LDA(At, 1, 1); PG8_STAGE(PG8_SB(1, 0), b3, voffB); PG8_STAGE(PG8_SB(1, 1), b3 + hstep, voffB); PG8_STAGE(PG8_SA(1, 0), a3, voffA);
            PG8_WAIT_V(8); PG8_WAIT_L(0); PG8_BAR; PG8_MMA(1, 0, At, B0); PG8_MMA(1, 1, At, B1); PG8_BAR; PG8_SCHED;
            } else {
            PG8_LDB(B0, 0, 0); PG8_SCHED; PG8_LDA(At, 0, 0); PG8_STAGE(PG8_SA(1, 1), a1 + hstep, voffA);
            PG8_WAIT_L(8); PG8_BAR; PG8_WAIT_L(0); PG8_MMA(0, 0, At, B0); PG8_BAR; PG8_SCHED;
            PG8_LDB(B1, 0, 1); PG8_STAGE(PG8_SB(0, 0), b2, voffB);
            PG8_BAR; PG8_WAIT_L(0); PG8_MMA(0, 1, At, B1); PG8_BAR;
            PG8_LDA(At, 0, 1); PG8_STAGE(PG8_SA(0, 0), a2, voffA);
            PG8_BAR; PG8_WAIT_L(0); PG8_MMA(1, 0, At, B0); PG8_BAR; PG8_SCHED;
            PG8_STAGE(PG8_SB(0, 1), b2 + hstep, voffB);
            PG8_WAIT_V(6); PG8_BAR; PG8_MMA(1, 1, At, B1); PG8_BAR;
            PG8_LDB(B0, 1, 0); PG8_SCHED; PG8_LDA(At, 1, 0); PG8_STAGE(PG8_SA(0, 1), a2 + hstep, voffA);
            PG8_WAIT_L(8); PG8_BAR; PG8_WAIT_L(0); PG8_MMA(0, 0, At, B0); PG8_BAR; PG8_SCHED;
            PG8_LDB(B1, 1, 1); PG8_STAGE(PG8_SB(1, 0), b3, voffB);
            PG8_BAR; PG8_WAIT_L(0); PG8_MMA(0, 1, At, B1); PG8_BAR;
            PG8_LDA(At, 1, 1); PG8_STAGE(PG8_SA(1, 0), a3, voffA);
            PG8_BAR; PG8_WAIT_L(0); PG8_MMA(1, 0, At, B0); PG8_BAR; PG8_SCHED;
            PG8_STAGE(PG8_SB(1, 1), b3 + hstep, voffB);
            PG8_WAIT_V(6); PG8_BAR; PG8_MMA(1, 1, At, B1); PG8_BAR;
            }
        }
        if constexpr (ALIGN_EPI) { if (wr == 0) PG8_BAR; }
        if constexpr (!Epi::AFTER_DRAIN) { E(acc, cur, wr, wc, fr, fq); S.done(cur); }
        if (!has_next) break;
#pragma unroll
        for (int a = 0; a < 2; ++a)
#pragma unroll
            for (int b = 0; b < 2; ++b)
#pragma unroll
                for (int m = 0; m < 4; ++m)
#pragma unroll
                    for (int n = 0; n < 2; ++n) acc[a][b][m][n] = (f32x4){0.f, 0.f, 0.f, 0.f};
        cur = nxt; cA = nA; cB = nB; ++ui;
        if constexpr (ALIGN_EPI) { if (wr == 1) PG8_BAR; }
    }
    PG8_WAIT_V(0);
    if constexpr (!ALIGN_EPI) { if (wr == 0) PG8_BAR; }
    PG8_BAR;
    if constexpr (Epi::AFTER_DRAIN) { E.fused(acc, cur, wr, wc, fr, fq, lds, wid, lane); S.done(cur); }
#undef PG8_SA
#undef PG8_SB
#undef PG8_STAGE
#undef PG8_LDA
#undef PG8_LDB
#undef PG8_MMA
#undef PG8_WAIT_V
#undef PG8_WAIT_L
#undef PG8_BAR
#undef PG8_SCHED
}
}
#define GAS __attribute__((address_space(1)))
#define LAS __attribute__((address_space(3)))
typedef unsigned short bf16;
typedef unsigned v4u __attribute__((ext_vector_type(4)));
typedef float f32x4 __attribute__((ext_vector_type(4)));
typedef short bf16x8 __attribute__((ext_vector_type(8)));
typedef GAS unsigned gu32;
typedef GAS unsigned long long gu64;
#define RLX_AGENT __ATOMIC_RELAXED, __HIP_MEMORY_SCOPE_AGENT
#define LDS_WAIT() asm volatile("s_waitcnt lgkmcnt(0)" ::: "memory")
#define VM_WAIT() asm volatile("s_waitcnt vmcnt(0)" ::: "memory")
__device__ __forceinline__ unsigned long long rt() { return __builtin_amdgcn_s_memrealtime(); }
__device__ __forceinline__ unsigned f2bf(float f) { unsigned u = __builtin_bit_cast(unsigned, f); return (u + 0x7fffu + ((u >> 16) & 1u)) >> 16; }
__device__ __forceinline__ unsigned pk2(float lo, float hi) { return f2bf(lo) | (f2bf(hi) << 16); }

#define XB_TMO      128
#define XB_XCNT(j)  (256  + 64 * (j))
#define XB_XSUB(j)  (1280 + 64 * (j))
#define XB_XGEN(j)  (2304 + 64 * (j))
#define XB_TOP      3328
#define XB_TOPGEN   3392
#define XCD_BAR_WORDS 3456
#define XB_SPIN_CAP (1u << 18)

__device__ __forceinline__ unsigned xb_ld(unsigned* p)              { return __hip_atomic_load(p, __ATOMIC_RELAXED, __HIP_MEMORY_SCOPE_AGENT); }
__device__ __forceinline__ unsigned xb_add(unsigned* p, unsigned v) { return __hip_atomic_fetch_add(p, v, __ATOMIC_RELAXED, __HIP_MEMORY_SCOPE_AGENT); }
__device__ __forceinline__ unsigned xb_xcc_id() { return (unsigned)__builtin_amdgcn_s_getreg((3 << 11) | 20) & 0xFu; }
#define XB_SPIN(cond, bar) do { unsigned _sp = 0; while (cond) { __builtin_amdgcn_s_sleep(1); \
    if ((++_sp & 255u) == 0u) { if (xb_ld(&(bar)[XB_TMO])) break; if (_sp > XB_SPIN_CAP) { atomicAdd(&(bar)[XB_TMO], 1u); break; } } } } while (0)

struct XcdBarrier {
    unsigned* bar; unsigned x;
    volatile LAS unsigned* st;
};

__device__ __forceinline__ XcdBarrier xcd_barrier_post(unsigned* bar, volatile LAS unsigned* st) {
    XcdBarrier b; b.bar = bar; b.x = xb_xcc_id(); b.st = st;
    if (threadIdx.x == 0) (void)xb_add(&bar[XB_XCNT(b.x)], 1u);
    return b;
}
__device__ __forceinline__ void xcd_barrier_complete(unsigned* bar, unsigned x, unsigned& nloc, unsigned& nx) {
    const unsigned G = gridDim.x * gridDim.y * gridDim.z;
    unsigned sum, cnt, mine, sp = 0u;
    for (;;) {
        sum = 0u; cnt = 0u; mine = 0u;
#pragma unroll
        for (unsigned j = 0; j < 16; ++j) { const unsigned c = xb_ld(&bar[XB_XCNT(j)]); sum += c; cnt += (c > 0u) ? 1u : 0u; mine = (j == x) ? c : mine; }
        if (sum == G) break;
        __builtin_amdgcn_s_sleep(1);
        if ((++sp & 255u) == 0u) { if (xb_ld(&bar[XB_TMO])) break; if (sp > XB_SPIN_CAP) { atomicAdd(&bar[XB_TMO], 1u); break; } }
    }
    nloc = mine > 0u ? mine : 1u; nx = cnt > 0u ? cnt : 1u;
}

__device__ __forceinline__ void xcd_barrier(const XcdBarrier& b) {
    asm volatile("s_waitcnt vmcnt(0)" ::: "memory");
    __syncthreads();
    if (threadIdx.x == 0) {
        unsigned* bar = b.bar;
        __builtin_amdgcn_s_waitcnt(0);
        unsigned nloc = b.st[0], nx = b.st[1];
        const bool first_ = (nloc == 0u) || (b.st[6] != 0u); b.st[6] = 0u;
        if (nloc == 0u) { xcd_barrier_complete(bar, b.x, nloc, nx); b.st[0] = nloc; b.st[1] = nx; }
        if (first_) __builtin_amdgcn_fence(__ATOMIC_ACQUIRE, "agent");
        const unsigned old = xb_add(&bar[XB_XSUB(b.x)], 1u);
        const unsigned gen = old / nloc;
        if (old + 1u == (gen + 1u) * nloc) {
            __builtin_amdgcn_fence(__ATOMIC_RELEASE, "agent");
            asm volatile("s_waitcnt vmcnt(0)" ::: "memory");
            const unsigned og = xb_add(&bar[XB_TOP], 1u);
            const unsigned tg = og / nx;
            if (og + 1u == (tg + 1u) * nx) xb_add(&bar[XB_TOPGEN], 1u);
            else XB_SPIN(xb_ld(&bar[XB_TOPGEN]) == tg, bar);
            __builtin_amdgcn_fence(__ATOMIC_ACQUIRE, "agent");
            xb_add(&bar[XB_XGEN(b.x)], 1u);
            asm volatile("s_waitcnt vmcnt(0)" ::: "memory");
        } else {
            XB_SPIN(xb_ld(&bar[XB_XGEN(b.x)]) == gen, bar);
            if (!first_) __builtin_amdgcn_fence(__ATOMIC_ACQUIRE, "agent");
            asm volatile("s_waitcnt vmcnt(0)" ::: "memory");
        }
    }
    __syncthreads();
}

constexpr int NWAVES = 8;
constexpr int BATCH = 8, SEQ = 4096, DM = 1024, MTOK = BATCH * SEQ, NMEM = 256, MEMROWS = BATCH * NMEM;
constexpr int NPROJ = 3072;
enum { S_AU = 0, S_AV = 1, S_AG = 2, S_BQ = 3, S_BK = 4, S_DG = 5, S_BG = 6, S_XC = 7, S_XS = 8, S_CG = 9, S_DQ = 10, S_BV = 11 };
constexpr float LOG2E = 1.4426950408889634f;
constexpr float QSCALE = 0.125f * LOG2E;
constexpr int IN_COLS = 2816;

constexpr size_t MiB = 1u << 20;
constexpr size_t WS_CTL = 0, CTL_ZERO_BYTES = 64 * 1024;
constexpr size_t WS_WIN = 2 * MiB;
constexpr size_t WS_WOUT = 14 * MiB;
constexpr size_t WS_WMKV = 18 * MiB;
constexpr size_t WS_WS = 20 * MiB;
constexpr size_t WS_F1 = 20 * MiB + 512 * 1024;
constexpr size_t WS_F2 = WS_F1 + 64 * 1024;
constexpr size_t WS_TW = WS_F2 + 64 * 1024;
constexpr size_t WS_BND = WS_TW + 64 * 1024;
constexpr size_t WS_MEMA = 22 * MiB;
constexpr size_t WS_MKV = 26 * MiB;
constexpr size_t WS_PART = 30 * MiB;
constexpr size_t WS_XB = 32 * MiB;
constexpr size_t WS_P = 96 * MiB;
constexpr size_t WS_Y = 288 * MiB;
constexpr size_t WS_T = 352 * MiB;
constexpr size_t WS_END = 384 * MiB;
constexpr int CW_BAR = 4096;

constexpr int RING_BYTES = 131072;
constexpr int ATT_K_OFF = 0, ATT_IMG_BYTES = 9 * 64 * 128, ATT_V_OFF = ATT_IMG_BYTES, ATT_BT_OFF = 2 * ATT_IMG_BYTES;
constexpr int LDSCTL_OFF = 155 * 1024, MISC_OFF = LDSCTL_OFF + 320;
constexpr int LDS_BYTES = 156 * 1024;
static_assert(ATT_BT_OFF + 15 * 32 * 4 <= LDSCTL_OFF && MISC_OFF + 128 <= LDS_BYTES, "LDS map");

typedef short s16x4 __attribute__((ext_vector_type(4)));
typedef unsigned u32x2v __attribute__((ext_vector_type(2)));

typedef const float* cfptr_t;
typedef const __attribute__((address_space(4))) cfptr_t* kargtab;
struct Frame {
    LAS unsigned char* lds;
    volatile LAS unsigned* MISC;
    gu32* ctl;
    int tid, lane, wave, vcu, G;
    kargtab in;
    float* out; unsigned char* ws;
};
enum { I_X = 0, I_MEM, I_NORMG, I_WIN, I_WOUT, I_LNG, I_LNB, I_WS, I_BS, I_NAQ, I_NAK, I_RPB, I_FNW, I_MEMNG, I_WMKV, I_MQ, I_MK };

constexpr size_t PLANE = (size_t)MTOK * 64;
__device__ __forceinline__ const bf16* pplane(const bf16* P, int slot, int h) { return P + (size_t)(slot * 4 + h) * PLANE; }
__device__ __forceinline__ const bf16* ptok(const bf16* P, int slot) { return P + (size_t)slot * 4 * PLANE; }
__device__ __forceinline__ float bf_lo(unsigned w) { return __uint_as_float(w << 16); }
__device__ __forceinline__ float bf_hi(unsigned w) { return __uint_as_float(w & 0xffff0000u); }
__device__ __forceinline__ unsigned pkbf(float lo, float hi) { return pg8::cvt_pk_bf16(lo, hi); }
__device__ __forceinline__ float silu_f(float x) { return x * __builtin_amdgcn_rcpf(1.0f + __builtin_amdgcn_exp2f(-LOG2E * x)); }
__device__ __forceinline__ float wave_sum(float v) {
    v += SWZ_XOR(v, 1); v += SWZ_XOR(v, 2); v += SWZ_XOR(v, 4); v += SWZ_XOR(v, 8); v += SWZ_XOR(v, 16);
    return pg8::red_add_x32(v);
}
__device__ __forceinline__ float wave_max(float v) {
    v = fmaxf(v, SWZ_XOR(v, 1)); v = fmaxf(v, SWZ_XOR(v, 2)); v = fmaxf(v, SWZ_XOR(v, 4)); v = fmaxf(v, SWZ_XOR(v, 8)); v = fmaxf(v, SWZ_XOR(v, 16));
    return pg8::red_max_x32(v);
}
__device__ __forceinline__ s16x4 tr_read(LAS const unsigned char* p) {
    typedef short v4i16_t __attribute__((ext_vector_type(4)));
    return __builtin_bit_cast(s16x4, __builtin_amdgcn_ds_read_tr16_b64_v4i16((LAS v4i16_t*)p));
}

__device__ __forceinline__ void tr_store(LAS const float* scr, bf16* dst, int K, int lane) {
    const int c = lane & 7;
#pragma unroll
    for (int j = 0; j < 4; ++j) { const int n = (lane >> 3) + 8 * j; const LAS float* s = scr + (8 * c) * 33 + n;
        v4u o; o.x = pkbf(s[0 * 33], s[1 * 33]); o.y = pkbf(s[2 * 33], s[3 * 33]); o.z = pkbf(s[4 * 33], s[5 * 33]); o.w = pkbf(s[6 * 33], s[7 * 33]);
        *(GAS v4u*)(dst + (size_t)n * K + 8 * c) = o; }
}
__device__ __forceinline__ void tr_plain_issue(const float* src, int ld, int lane, f32x4 (&v)[8]) {
#pragma unroll
    for (int it = 0; it < 8; ++it) v[it] = __builtin_nontemporal_load((const GAS f32x4*)(src + (size_t)(8 * it + (lane >> 3)) * ld + 4 * (lane & 7)));
}
__device__ __forceinline__ void tr_plain_finish(const f32x4 (&v)[8], const float* gk, bf16* dst, int K, LAS float* scr, int lane) {
#pragma unroll
    for (int it = 0; it < 8; ++it) { const int kk = 8 * it + (lane >> 3); const float g = gk ? gk[kk] : 1.0f; LAS float* d = scr + kk * 33 + 4 * (lane & 7);
        d[0] = v[it][0] * g; d[1] = v[it][1] * g; d[2] = v[it][2] * g; d[3] = v[it][3] * g; }
    LDS_WAIT(); asm volatile("" ::: "memory");
    tr_store(scr, dst, K, lane);
    LDS_WAIT(); asm volatile("" ::: "memory");
}
typedef float f32x16 __attribute__((ext_vector_type(16)));
__device__ __forceinline__ void tr_item_fold(const float* winrow  , const float* gk, const float* wf  , LAS const float* tab  ,
                                             bf16* dst, LAS float* scr, LAS float* scr2, int lane) {
    const int i = lane & 31, hk = lane >> 5;
    {   float wb[32];
#pragma unroll
        for (int s = 0; s < 32; ++s) wb[s] = wf[(32 * hk + s) * 64 + i];
#pragma nounroll
        for (int mt = 0; mt < 2; ++mt) {
            f32x16 m0 = {};
#pragma unroll
            for (int s = 0; s < 32; ++s) m0 = __builtin_amdgcn_mfma_f32_32x32x2f32(tab[((32 * mt + i) * (32 * hk + s)) & 63], wb[s], m0, 0, 0, 0);
#pragma unroll
            for (int r = 0; r < 16; ++r) { const int d = 32 * mt + (r & 3) + 8 * (r >> 2) + 4 * hk; scr2[d * 33 + i] = m0[r] * 0.125f; }
        }
    }
    LDS_WAIT(); asm volatile("" ::: "memory");
#pragma nounroll
    for (int mt = 0; mt < 2; ++mt) {
        f32x4 wv[8];
#pragma unroll
        for (int j = 0; j < 8; ++j) wv[j] = *(const GAS f32x4*)(winrow + (size_t)(32 * mt + i) * IN_COLS + 32 * hk + 4 * j);
        f32x16 a0 = {};
#pragma unroll
        for (int s = 0; s < 32; ++s) a0 = __builtin_amdgcn_mfma_f32_32x32x2f32(wv[s >> 2][s & 3], scr2[(32 * hk + s) * 33 + i], a0, 0, 0, 0);
#pragma unroll
        for (int r = 0; r < 16; ++r) { const int kk = 32 * mt + (r & 3) + 8 * (r >> 2) + 4 * hk; scr[kk * 33 + i] = a0[r] * gk[kk]; }
    }
    LDS_WAIT(); asm volatile("" ::: "memory");
    tr_store(scr, dst, 1024, lane);
    LDS_WAIT(); asm volatile("" ::: "memory");
}
__device__ __forceinline__ int src_col_of_slot(int t) {
    return t == S_AU ? 0 : t == S_AV ? 256 : t == S_AG ? 512 : t == S_BQ ? 768 : t == S_BK ? 1024 : t == S_BV ? 1280 : t == S_BG ? 1536 : t == S_CG ? 2048 : t == S_DQ ? 2304 : 2560; }

struct ItemDesc { const float* src; const float* gk; const float* wf; bf16* dst; int ld; int kind; int sel; };
__device__ __forceinline__ void p0_item_decode(Frame& F, int it, ItemDesc& d) {
    bf16* WinT = (bf16*)(F.ws + WS_WIN); bf16* WoutT = (bf16*)(F.ws + WS_WOUT); bf16* WmkvT = (bf16*)(F.ws + WS_WMKV);
    constexpr int N_IN = 2 * 16 * 96, N_OUT = 2 * 16 * 32, N_KV = 2 * 16 * 16;
    int r = it; d.kind = 0; d.wf = nullptr; d.sel = 0; d.gk = nullptr; d.src = nullptr; d.dst = nullptr; d.ld = 0;
    if (r >= N_IN + N_OUT + N_KV) { d.kind = -1; return; }
    if (r < N_IN) { const int l = r / 1536; r -= l * 1536; const int kb = r / 96, nb = r % 96, pn = nb >> 3, bj = (nb >> 2) & 1, wc = nb & 3, k0 = 64 * kb;
        d.dst = WinT + ((size_t)l * NPROJ + 32 * nb) * 1024 + k0; d.gk = F.in[I_NORMG] + l * 1024 + k0; d.ld = IN_COLS;
        const float* win = F.in[I_WIN] + (size_t)l * 1024 * IN_COLS + (size_t)k0 * IN_COLS;
        if (pn == S_XC || pn == S_XS) { d.kind = 1; d.sel = (pn == S_XS); d.src = win + 1792 + 64 * wc; d.wf = F.in[I_FNW] + (size_t)((l * 4 + wc) * 64) * 64 + 32 * bj; }
        else d.src = win + src_col_of_slot(pn) + 64 * wc + 32 * bj;
        return; }
    r -= N_IN;
    if (r < N_OUT) { const int l = r / 512; r -= l * 512; const int kb = r / 32, nb = r % 32, k0 = 64 * kb;
        d.src = F.in[I_WOUT] + (size_t)l * 1024 * 1024 + (size_t)k0 * 1024 + 32 * nb; d.ld = 1024; d.dst = WoutT + ((size_t)l * 1024 + 32 * nb) * 1024 + k0; return; }
    r -= N_OUT;
    { const int l = r / 256; r -= l * 256; const int kb = r / 16, nb = r % 16, k0 = 64 * kb;
      d.src = F.in[I_WMKV] + (size_t)l * 1024 * 512 + (size_t)k0 * 512 + 32 * nb; d.ld = 512; d.gk = F.in[I_MEMNG] + l * 1024 + k0; d.dst = WmkvT + ((size_t)l * 512 + 32 * nb) * 1024 + k0; }
}
#define FRESH_BASES(F) do { unsigned char* w_ = (F).ws; float* o_ = (F).out; kargtab i_ = (F).in; asm volatile("" : "+s"(w_), "+s"(o_), "+s"(i_)); (F).ws = w_; (F).out = o_; (F).in = i_; (F).ctl = (gu32*)(w_ + WS_CTL); } while (0)
#define FRESH_LANES(F) do { int t_ = (F).wave * 64 + (int)__builtin_amdgcn_mbcnt_hi(~0u, __builtin_amdgcn_mbcnt_lo(~0u, 0u)); asm volatile("" : "+v"(t_)); (F).tid = t_; (F).lane = t_ & 63; FRESH_BASES(F); } while (0)
__device__ __forceinline__ void p0_prologue(Frame& F) {
    FRESH_LANES(F);
    LAS float* tabc = (LAS float*)(F.lds + 8 * 16896);
    LAS float* tabs = tabc + 64;
    if (F.tid < 64) { float s, c; sincospif((float)F.tid * (1.0f / 32.0f), &s, &c); tabc[F.tid] = c; tabs[F.tid] = s; }
    __syncthreads();
    LAS float* scr = (LAS float*)(F.lds + F.wave * 16896);
    LAS float* scr2 = scr + 64 * 33;
    constexpr int NHW = NWAVES / 2;
    const bool xrole = F.wave < NHW;
    const int gw = F.vcu * NHW + (F.wave & (NHW - 1)), NGW = F.G * NHW;
    bf16* WinT = (bf16*)(F.ws + WS_WIN); bf16* WoutT = (bf16*)(F.ws + WS_WOUT); bf16* WmkvT = (bf16*)(F.ws + WS_WMKV);
    if (xrole) { bf16* XB = (bf16*)(F.ws + WS_XB); float* part = (float*)(F.ws + WS_PART);
#define X_ISSUE(V, M0) do { if ((M0) < MTOK) { _Pragma("unroll") for (int r = 0; r < 4; ++r) { const GAS f32x4* xr = (const GAS f32x4*)(F.in[I_X] + (size_t)((M0) + r) * DM) + 2 * F.lane; \
            (V)[r][0] = __builtin_nontemporal_load(xr); (V)[r][1] = __builtin_nontemporal_load(xr + 1); (V)[r][2] = __builtin_nontemporal_load(xr + 128); (V)[r][3] = __builtin_nontemporal_load(xr + 129); } } } while (0)
#define X_FINISH(V, M0) do { if ((M0) < MTOK) { _Pragma("unroll") for (int r = 0; r < 4; ++r) { float s_ = 0.f; \
            _Pragma("unroll") for (int j = 0; j < 4; ++j) s_ += ((V)[r][j][0] * (V)[r][j][0] + (V)[r][j][1] * (V)[r][j][1]) + ((V)[r][j][2] * (V)[r][j][2] + (V)[r][j][3] * (V)[r][j][3]); \
            s_ = wave_sum(s_); \
            GAS v4u* o16 = (GAS v4u*)(XB + (size_t)((M0) + r) * DM) + F.lane; \
            v4u w0, w1; w0.x = pkbf((V)[r][0][0], (V)[r][0][1]); w0.y = pkbf((V)[r][0][2], (V)[r][0][3]); w0.z = pkbf((V)[r][1][0], (V)[r][1][1]); w0.w = pkbf((V)[r][1][2], (V)[r][1][3]); \
            w1.x = pkbf((V)[r][2][0], (V)[r][2][1]); w1.y = pkbf((V)[r][2][2], (V)[r][2][3]); w1.z = pkbf((V)[r][3][0], (V)[r][3][1]); w1.w = pkbf((V)[r][3][2], (V)[r][3][3]); \
            o16[0] = w0; o16[64] = w1; \
            if (F.lane < 4) *(GAS f32x4*)(part + (size_t)((M0) + r) * 16 + 4 * F.lane) = (f32x4){F.lane == 0 ? s_ : 0.f, 0.f, 0.f, 0.f}; } } } while (0)
      const int step = NGW * 4;
      f32x4 va[4][4], vb[4][4];
      X_ISSUE(va, gw * 4);
      for (int m0 = gw * 4; m0 < MTOK; m0 += 2 * step) {
          X_ISSUE(vb, m0 + step);
          X_FINISH(va, m0);
          X_ISSUE(va, m0 + 2 * step);
          X_FINISH(vb, m0 + step);
      }
#undef X_ISSUE
#undef X_FINISH
      if (F.tid == 0) { unsigned* bar = (unsigned*)(F.ctl + CW_BAR); const unsigned x = xb_xcc_id(); unsigned nloc = 1u, nx = 1u;
          xcd_barrier_complete(bar, x, nloc, nx);
          unsigned ok = (F.G == 256) ? 1u : 0u, rank = 0u, npop = 0u;
#pragma unroll
          for (unsigned j = 0; j < 16; ++j) { const unsigned c = xb_ld(&bar[XB_XCNT(j)]); if (c != 0u && c != 32u) ok = 0u; if (c) { ++npop; if (j < x) ++rank; } }
          if (npop != 8u) ok = 0u;
          F.MISC[8] = nloc; F.MISC[9] = nx; F.MISC[11] = ok; F.MISC[12] = rank; F.MISC[14] = 1u; }
    } else {
    {   ItemDesc d0, d1, d2; f32x4 i0[8], i1[8], i2[8];
        p0_item_decode(F, gw, d0); p0_item_decode(F, gw + NGW, d1); p0_item_decode(F, gw + 2 * NGW, d2);
        if (d0.kind == 0) tr_plain_issue(d0.src, d0.ld, F.lane, i0);
        if (d1.kind == 0) tr_plain_issue(d1.src, d1.ld, F.lane, i1);
        if (d2.kind == 0) tr_plain_issue(d2.src, d2.ld, F.lane, i2);
        if (d0.kind == 0) tr_plain_finish(i0, d0.gk, d0.dst, 1024, scr, F.lane);
        if (d1.kind == 0) tr_plain_finish(i1, d1.gk, d1.dst, 1024, scr, F.lane);
        if (d2.kind == 0) tr_plain_finish(i2, d2.gk, d2.dst, 1024, scr, F.lane);
        if (d0.kind == 1) tr_item_fold(d0.src, d0.gk, d0.wf, d0.sel ? tabs : tabc, d0.dst, scr, scr2, F.lane);
        if (d1.kind == 1) tr_item_fold(d1.src, d1.gk, d1.wf, d1.sel ? tabs : tabc, d1.dst, scr, scr2, F.lane);
        if (d2.kind == 1) tr_item_fold(d2.src, d2.gk, d2.wf, d2.sel ? tabs : tabc, d2.dst, scr, scr2, F.lane);
    }
    {   ItemDesc d0, d1; f32x4 i0[8], i1[8];
        p0_item_decode(F, gw + 3 * NGW, d0); p0_item_decode(F, gw + 4 * NGW, d1);
        if (d0.kind == 0) tr_plain_issue(d0.src, d0.ld, F.lane, i0);
        if (d1.kind == 0) tr_plain_issue(d1.src, d1.ld, F.lane, i1);
        if (d0.kind == 0) tr_plain_finish(i0, d0.gk, d0.dst, 1024, scr, F.lane);
        if (d1.kind == 0) tr_plain_finish(i1, d1.gk, d1.dst, 1024, scr, F.lane);
        if (d0.kind == 1) tr_item_fold(d0.src, d0.gk, d0.wf, d0.sel ? tabs : tabc, d0.dst, scr, scr2, F.lane);
        if (d1.kind == 1) tr_item_fold(d1.src, d1.gk, d1.wf, d1.sel ? tabs : tabc, d1.dst, scr, scr2, F.lane);
        for (int it = gw + 5 * NGW; it < 2 * 16 * 96 + 2 * 16 * 32 + 2 * 16 * 16; it += NGW) {
            ItemDesc d; p0_item_decode(F, it, d);
            if (d.kind == 1) tr_item_fold(d.src, d.gk, d.wf, d.sel ? tabs : tabc, d.dst, scr, scr2, F.lane);
            else if (d.kind == 0) { f32x4 iv[8]; tr_plain_issue(d.src, d.ld, F.lane, iv); tr_plain_finish(iv, d.gk, d.dst, 1024, scr, F.lane); } }
    }
    { bf16* WsB = (bf16*)(F.ws + WS_WS); const float* ws_in = F.in[I_WS];
      for (int i = gw * 64 + F.lane; i < 2 * 4 * 128 * 128 / 2; i += NGW * 64) ((GAS unsigned*)WsB)[i] = pkbf(ws_in[2 * i], ws_in[2 * i + 1]);
      bf16* F1 = (bf16*)(F.ws + WS_F1);
      for (int i = gw * 64 + F.lane; i < 128 * 128; i += NGW * 64) { const int m = i >> 7, kk = i & 127, part = m >> 6, k1 = m & 63, src = kk >> 6, s1 = kk & 63;
          float s, c; sincospif((float)((k1 * s1) & 63) * (1.0f / 32.0f), &s, &c);
          const float v = (part == 0) ? (src == 0 ? c : -s) : (src == 0 ? -s : -c);
          F1[i] = (bf16)(pkbf(v * 0.125f, 0.f) & 0xffffu); }
      bf16* F2 = (bf16*)(F.ws + WS_F2);
      for (int i = gw * 64 + F.lane; i < 64 * 128; i += NGW * 64) { const int k2 = i >> 7, kk = i & 127, src = kk >> 6, s2 = kk & 63;
          float s, c; sincospif((float)((k2 * s2) & 63) * (1.0f / 32.0f), &s, &c);
          F2[i] = (bf16)(pkbf((src == 0 ? c : s) * 0.125f, 0.f) & 0xffffu); }
      float* TW = (float*)(F.ws + WS_TW);
      for (int i = gw * 64 + F.lane; i < 64 * 64; i += NGW * 64) { const int s2 = i >> 6, k1 = i & 63; float s, c; sincospif((float)(s2 * k1) * (1.0f / 2048.0f), &s, &c); TW[2 * i] = c; TW[2 * i + 1] = s; }
    }
    if (gw < 16) { const int l = gw / 8, j = gw % 8; float* BND = (float*)(F.ws + WS_BND) + 8 * l;
        if (j < 2) { const float a = wave_max(fabsf((j == 0 ? F.in[I_NAK] : F.in[I_MK])[64 * l + F.lane])); if (F.lane == 0) BND[j] = 8.08f * a; }
        else if (j >= 6) { const float a = wave_max(fabsf((j == 6 ? F.in[I_NAQ] : F.in[I_MQ])[64 * l + F.lane])); if (F.lane == 0) BND[j] = 8.08f * QSCALE * a; }
        else { const int h = j - 2; float v[8];
#pragma unroll
            for (int k = 0; k < 8; ++k) { const int i = F.lane + 64 * k; v[k] = i < 15 * 31 ? fabsf(F.in[I_RPB][(l * 4 + h) * 15 * 31 + i]) : 0.f; }
            float m = fmaxf(fmaxf(fmaxf(v[0], v[1]), fmaxf(v[2], v[3])), fmaxf(fmaxf(v[4], v[5]), fmaxf(v[6], v[7])));
            m = wave_max(m); if (F.lane == 0) BND[2 + h] = LOG2E * m; }
    }
    { bf16* memA = (bf16*)(F.ws + WS_MEMA);
      for (int m = gw; m < MEMROWS; m += NGW) { const GAS f32x4* xr = (const GAS f32x4*)(F.in[I_MEM] + (size_t)m * DM) + F.lane; f32x4 v[4]; float s = 0.f;
#pragma unroll
          for (int j = 0; j < 4; ++j) { v[j] = __builtin_nontemporal_load(xr + 64 * j); s += (v[j][0] * v[j][0] + v[j][1] * v[j][1]) + (v[j][2] * v[j][2] + v[j][3] * v[j][3]); }
          const float rstd = 1.0f / sqrtf(wave_sum(s) * (1.0f / DM) + 1e-6f);
          GAS u32x2v* o8 = (GAS u32x2v*)(memA + (size_t)m * DM) + F.lane;
#pragma unroll
          for (int j = 0; j < 4; ++j) { u32x2v w; w.x = pkbf(v[j][0] * rstd, v[j][1] * rstd); w.y = pkbf(v[j][2] * rstd, v[j][3] * rstd); o8[64 * j] = w; } }
    }
    }
}

constexpr int IMG_BYTES = 65536;
__device__ __forceinline__ int img_swz(int row) { return ((row & 3) << 5) | (((row >> 3) & 1) << 7); }
template <int NT>
__device__ __forceinline__ void spatial_core(LAS const unsigned char* img, const bf16x8 (&bw)[4][NT], int chbase, int lane, f32x4 (&acc)[4][NT]) {
    const int g = lane >> 4, r = lane & 15, q = r >> 2, p = r & 3;
    const int sw = (q << 5) | ((g & 1) << 7);
#pragma unroll
    for (int mt = 0; mt < 4; ++mt)
#pragma unroll
        for (int nt = 0; nt < NT; ++nt) acc[mt][nt] = (f32x4){0.f, 0.f, 0.f, 0.f};
#pragma unroll
    for (int ks = 0; ks < 4; ++ks) {
        const int row0 = ks * 32 + g * 8 + q;
#pragma unroll
        for (int mt = 0; mt < 4; ++mt) {
            const int cb = (2 * chbase + 64 * (mt >> 1) + 16 * p + 8 * (mt & 1)) ^ sw;
            const s16x4 lo = tr_read(img + row0 * 512 + cb), hi = tr_read(img + (row0 + 4) * 512 + cb);
            const bf16x8 av = (bf16x8){lo[0], lo[1], lo[2], lo[3], hi[0], hi[1], hi[2], hi[3]};
#pragma unroll
            for (int nt = 0; nt < NT; ++nt) acc[mt][nt] = __builtin_amdgcn_mfma_f32_16x16x32_bf16(av, bw[ks][nt], acc[mt][nt], 0, 0, 0);
        }
    }
}
template <int NT>
__device__ __forceinline__ void spatial_core_stream(LAS const unsigned char* img, const bf16* Amat, const int (&arow)[NT], int chbase, int lane, f32x4 (&acc)[4][NT]) {
    const int g = lane >> 4, r = lane & 15, q = r >> 2, p = r & 3;
    const int sw = (q << 5) | ((g & 1) << 7);
#pragma unroll
    for (int mt = 0; mt < 4; ++mt)
#pragma unroll
        for (int nt = 0; nt < NT; ++nt) acc[mt][nt] = (f32x4){0.f, 0.f, 0.f, 0.f};
    bf16x8 bwc[NT], bwn[NT];
#pragma unroll
    for (int nt = 0; nt < NT; ++nt) bwc[nt] = *(const GAS bf16x8*)(Amat + (size_t)(arow[nt] + r) * 128 + g * 8);
#pragma unroll
    for (int ks = 0; ks < 4; ++ks) {
        if (ks < 3) {
#pragma unroll
            for (int nt = 0; nt < NT; ++nt) bwn[nt] = *(const GAS bf16x8*)(Amat + (size_t)(arow[nt] + r) * 128 + (ks + 1) * 32 + g * 8); }
        const int row0 = ks * 32 + g * 8 + q;
#pragma unroll
        for (int mt = 0; mt < 4; ++mt) {
            const int cb = (2 * chbase + 64 * (mt >> 1) + 16 * p + 8 * (mt & 1)) ^ sw;
            const s16x4 lo = tr_read(img + row0 * 512 + cb), hi = tr_read(img + (row0 + 4) * 512 + cb);
            const bf16x8 av = (bf16x8){lo[0], lo[1], lo[2], lo[3], hi[0], hi[1], hi[2], hi[3]};
#pragma unroll
            for (int nt = 0; nt < NT; ++nt) acc[mt][nt] = __builtin_amdgcn_mfma_f32_16x16x32_bf16(av, bwc[nt], acc[mt][nt], 0, 0, 0);
        }
#pragma unroll
        for (int nt = 0; nt < NT; ++nt) bwc[nt] = bwn[nt];
    }
}
#define LOAD_BW(BW, NT_, AMAT, AROW) do { _Pragma("unroll") for (int ks_ = 0; ks_ < 4; ++ks_) _Pragma("unroll") for (int nt_ = 0; nt_ < (NT_); ++nt_) \
    (BW)[ks_][nt_] = *(const GAS bf16x8*)((AMAT) + (size_t)((AROW)[nt_] + (F.lane & 15)) * 128 + ks_ * 32 + (F.lane >> 4) * 8); } while (0)
struct ImgRegs { v4u r[8]; };
#define IMG_ISSUE(R, ROWPTR_EXPR) do { _Pragma("unroll") for (int it_ = 0; it_ < 8; ++it_) { const int id_ = F.tid + 512 * it_, kk = id_ >> 5, c_ = id_ & 31; \
        (R).r[it_] = *(const GAS v4u*)((ROWPTR_EXPR) + 8 * c_); } } while (0)
#define IMG_COMMIT(R, IMG) do { _Pragma("unroll") for (int it_ = 0; it_ < 8; ++it_) { const int id_ = F.tid + 512 * it_, kk = id_ >> 5, c_ = id_ & 31; \
        *(LAS v4u*)((IMG) + kk * 512 + ((16 * c_) ^ img_swz(kk))) = (R).r[it_]; } } while (0)

__device__ __forceinline__ void store8bf(bf16* p, const f32x4& a, const f32x4& b) { v4u w; w.x = pkbf(a[0], a[1]); w.y = pkbf(a[2], a[3]); w.z = pkbf(b[0], b[1]); w.w = pkbf(b[2], b[3]); *(GAS v4u*)p = w; }
__device__ __forceinline__ void load8bf(const bf16* p, f32x4& a, f32x4& b) { const v4u w = *(const GAS v4u*)p; a[0] = bf_lo(w.x); a[1] = bf_hi(w.x); a[2] = bf_lo(w.y); a[3] = bf_hi(w.y); b[0] = bf_lo(w.z); b[1] = bf_hi(w.z); b[2] = bf_lo(w.w); b[3] = bf_hi(w.w); }
__device__ __forceinline__ f32x4 silu4(const f32x4& x) { return (f32x4){silu_f(x[0]), silu_f(x[1]), silu_f(x[2]), silu_f(x[3])}; }
__device__ __forceinline__ void store4bf(bf16* p, float a, float b, float c, float d) { u32x2v w; w.x = pkbf(a, b); w.y = pkbf(c, d); *(GAS u32x2v*)p = w; }
__device__ __forceinline__ void load4bf(const bf16* p, float (&o)[4]) { const u32x2v w = *(const GAS u32x2v*)p; o[0] = bf_lo(w.x); o[1] = bf_hi(w.x); o[2] = bf_lo(w.y); o[3] = bf_hi(w.y); }

__device__ __forceinline__ void gmlp_issue(Frame& F, ImgRegs& R, int b, int chunk) {
    const bf16* P = (const bf16*)(F.ws + WS_P); const int tok0 = b * SEQ + 128 * chunk, l32 = F.lane & 31, half = F.lane >> 5;
#pragma unroll
    for (int it = 0; it < 8; ++it) R.r[it] = *(const GAS v4u*)(pplane(P, S_AV, l32 >> 3) + (size_t)(tok0 + 16 * F.wave + 2 * it + half) * 64 + 8 * (l32 & 7));
}
__device__ __forceinline__ void gmlp_commit(Frame& F, const ImgRegs& R, LAS unsigned char* img, int l) {
    const int l32 = F.lane & 31, half = F.lane >> 5, c0 = 8 * l32;
    float lg[8], lb[8];
#pragma unroll
    for (int j = 0; j < 8; ++j) { lg[j] = F.in[I_LNG][l * 256 + c0 + j]; lb[j] = F.in[I_LNB][l * 256 + c0 + j]; }
#pragma unroll
    for (int it = 0; it < 8; ++it) { const int tl = 16 * F.wave + 2 * it + half; const v4u raw = R.r[it];
        float x[8] = {bf_lo(raw.x), bf_hi(raw.x), bf_lo(raw.y), bf_hi(raw.y), bf_lo(raw.z), bf_hi(raw.z), bf_lo(raw.w), bf_hi(raw.w)};
        float s = ((x[0] + x[1]) + (x[2] + x[3])) + ((x[4] + x[5]) + (x[6] + x[7]));
        s += SWZ_XOR(s, 1); s += SWZ_XOR(s, 2); s += SWZ_XOR(s, 4); s += SWZ_XOR(s, 8); s += SWZ_XOR(s, 16);
        const float mean = s * (1.0f / 256.0f); float v = 0.f;
#pragma unroll
        for (int j = 0; j < 8; ++j) { x[j] -= mean; v += x[j] * x[j]; }
        v += SWZ_XOR(v, 1); v += SWZ_XOR(v, 2); v += SWZ_XOR(v, 4); v += SWZ_XOR(v, 8); v += SWZ_XOR(v, 16);
        const float rstd = __builtin_amdgcn_rsqf(v * (1.0f / 256.0f) + 1e-6f);
#pragma unroll
        for (int j = 0; j < 8; ++j) x[j] = x[j] * rstd * lg[j] + lb[j];
        v4u o; o.x = pkbf(x[0], x[1]); o.y = pkbf(x[2], x[3]); o.z = pkbf(x[4], x[5]); o.w = pkbf(x[6], x[7]);
        *(LAS v4u*)(img + tl * 512 + ((2 * c0) ^ img_swz(tl))) = o; }
}
__device__ __forceinline__ void unpack8(const v4u& w, f32x4& a, f32x4& b) { a[0] = bf_lo(w.x); a[1] = bf_hi(w.x); a[2] = bf_lo(w.y); a[3] = bf_hi(w.y); b[0] = bf_lo(w.z); b[1] = bf_hi(w.z); b[2] = bf_lo(w.w); b[3] = bf_hi(w.w); }
__device__ __forceinline__ void gmlp_compute(Frame& F, LAS const unsigned char* img, const bf16x8 (&bw)[4][4], int l, int b, int chunk) {
    const bf16* P = (const bf16*)(F.ws + WS_P); bf16* Y = (bf16*)(F.ws + WS_Y);
    const int tok0 = b * SEQ + 128 * chunk, w = F.wave, lane = F.lane, h = w >> 1, ph = w & 1, g = lane >> 4, r = lane & 15;
    f32x4 acc[4][4];
    spatial_core<4>(img, bw, 64 * h, lane, acc);
    v4u uu[4][2], gg[4][2];
#pragma unroll
    for (int nt = 0; nt < 4; ++nt) { const size_t tok = (size_t)(tok0 + 64 * ph + 16 * nt + r);
#pragma unroll
        for (int t = 0; t < 2; ++t) { uu[nt][t] = *(const GAS v4u*)(pplane(P, S_AU, h) + tok * 64 + 32 * t + 8 * g); gg[nt][t] = *(const GAS v4u*)(pplane(P, S_AG, h) + tok * 64 + 32 * t + 8 * g); } }
    __builtin_amdgcn_sched_barrier(0);
#pragma unroll
    for (int nt = 0; nt < 4; ++nt) { const int p = 64 * ph + 16 * nt + r; const size_t tok = (size_t)(tok0 + p); const float bs = F.in[I_BS][(l * 4 + h) * 128 + p];
#pragma unroll
        for (int t = 0; t < 2; ++t) { const int ch = 64 * h + 32 * t + 8 * g; f32x4 u0, u1, g0, g1; unpack8(uu[nt][t], u0, u1); unpack8(gg[nt][t], g0, g1);
            store8bf(Y + tok * DM + ch, u0 * (acc[2 * t][nt] + bs) * silu4(g0), u1 * (acc[2 * t + 1][nt] + bs) * silu4(g1)); } }
}
__device__ __forceinline__ void fft1_compute(Frame& F, LAS const unsigned char* img, const bf16x8 (&bw)[4][4], int b, int s2) {
    bf16* T = (bf16*)(F.ws + WS_T);
    const int w = F.wave, lane = F.lane, cs = w >> 1, kh = w & 1, g = lane >> 4, r = lane & 15;
    f32x4 acc[4][4];
    spatial_core<4>(img, bw, 64 * cs, lane, acc);
    const float* TW = (const float*)(F.ws + WS_TW);
#pragma unroll
    for (int a = 0; a < 2; ++a) { const int k1 = 32 * kh + 16 * a + r; const float ct = TW[2 * (s2 * 64 + k1)], st = TW[2 * (s2 * 64 + k1) + 1];
        bf16* tr_ = T + ((size_t)((b * 64 + k1) * 2 + 0) * 64 + s2) * 256; bf16* ti_ = tr_ + (size_t)64 * 256;
#pragma unroll
        for (int mt = 0; mt < 4; ++mt) { const int ch = 64 * cs + 32 * (mt >> 1) + 8 * g + 4 * (mt & 1); const f32x4 Ar = acc[mt][a], Ai = acc[mt][a + 2];
            store4bf(tr_ + ch, Ar[0] * ct + Ai[0] * st, Ar[1] * ct + Ai[1] * st, Ar[2] * ct + Ai[2] * st, Ar[3] * ct + Ai[3] * st);
            store4bf(ti_ + ch, Ai[0] * ct - Ar[0] * st, Ai[1] * ct - Ar[1] * st, Ai[2] * ct - Ar[2] * st, Ai[3] * ct - Ar[3] * st); } }
}
__device__ __forceinline__ void fft2_compute(Frame& F, LAS const unsigned char* img, const bf16x8 (&bw)[4][2], int b, int k1) {
    const bf16* P = (const bf16*)(F.ws + WS_P); bf16* Y = (bf16*)(F.ws + WS_Y);
    const int w = F.wave, lane = F.lane, cs = w >> 1, k2h = w & 1, g = lane >> 4, r = lane & 15;
    f32x4 gt[2][2][2];
#pragma unroll
    for (int nt = 0; nt < 2; ++nt) { const size_t tok = (size_t)(b * SEQ + 64 * (32 * k2h + 16 * nt + r) + k1);
#pragma unroll
        for (int t = 0; t < 2; ++t) load8bf(pplane(P, S_CG, cs) + tok * 64 + 32 * t + 8 * g, gt[nt][t][0], gt[nt][t][1]); }
    f32x4 acc[4][2];
    spatial_core<2>(img, bw, 64 * cs, lane, acc);
#pragma unroll
    for (int nt = 0; nt < 2; ++nt) { const size_t tok = (size_t)(b * SEQ + 64 * (32 * k2h + 16 * nt + r) + k1);
#pragma unroll
        for (int t = 0; t < 2; ++t) store8bf(Y + tok * DM + 512 + 64 * cs + 32 * t + 8 * g, acc[2 * t][nt] * silu4(gt[nt][t][0]), acc[2 * t + 1][nt] * silu4(gt[nt][t][1])); }
}
__device__ __forceinline__ void spatial_seq(Frame& F, int l, int u) {
    FRESH_LANES(F);
    const int b = u >> 5, chunk = u & 31, s2a = 2 * (u & 31), w = F.wave;
    const bf16* P = (const bf16*)(F.ws + WS_P);
    LAS unsigned char* img0 = F.lds; LAS unsigned char* img1 = F.lds + IMG_BYTES;

    ImgRegs R;
    gmlp_issue(F, R, b, chunk);
    bf16x8 bw[4][4];
    { const int h = w >> 1, ph = w & 1; const int arow[4] = {h * 128 + 64 * ph, h * 128 + 64 * ph + 16, h * 128 + 64 * ph + 32, h * 128 + 64 * ph + 48};
      LOAD_BW(bw, 4, (const bf16*)(F.ws + WS_WS) + (size_t)l * 4 * 128 * 128, arow); }
    gmlp_commit(F, R, img0, l);
    __syncthreads();

    IMG_ISSUE(R, ptok(P, kk < 64 ? S_XC : S_XS) + (size_t)(b * SEQ + 64 * (kk & 63) + s2a) * 256);
    gmlp_compute(F, img0, bw, l, b, chunk);

    { const int kh = w & 1; const int arow[4] = {32 * kh, 32 * kh + 16, 64 + 32 * kh, 64 + 32 * kh + 16};
      LOAD_BW(bw, 4, (const bf16*)(F.ws + WS_F1), arow); }
    IMG_COMMIT(R, img1);
    __syncthreads();

    IMG_ISSUE(R, ptok(P, kk < 64 ? S_XC : S_XS) + (size_t)(b * SEQ + 64 * (kk & 63) + s2a + 1) * 256);
    fft1_compute(F, img1, bw, b, s2a);

    IMG_COMMIT(R, img0);
    __syncthreads();

    fft1_compute(F, img0, bw, b, s2a + 1);
    __syncthreads();

}
__device__ __forceinline__ void fft2_seq(Frame& F, int u) {
    FRESH_LANES(F);
    const int b = u >> 5, k1a = 2 * (u & 31), w = F.wave;
    const bf16* T = (const bf16*)(F.ws + WS_T);
    LAS unsigned char* img0 = F.lds; LAS unsigned char* img1 = F.lds + IMG_BYTES;
    ImgRegs R0, R1;
    IMG_ISSUE(R0, T + ((size_t)(b * 64 + k1a) * 128 + kk) * 256);
    IMG_ISSUE(R1, T + ((size_t)(b * 64 + k1a + 1) * 128 + kk) * 256);
    bf16x8 bw[4][2];
    { const int k2h = w & 1; const int arow[2] = {32 * k2h, 32 * k2h + 16}; LOAD_BW(bw, 2, (const bf16*)(F.ws + WS_F2), arow); }
    IMG_COMMIT(R0, img0); IMG_COMMIT(R1, img1);
    __syncthreads();
    fft2_compute(F, img0, bw, b, k1a);
    fft2_compute(F, img1, bw, b, k1a + 1);
    __syncthreads();
}

__device__ __forceinline__ int att_f(int row) { return ((row >> 1) & 1) | (((row >> 3) & 1) << 1); }
#define ATT_SB() __builtin_amdgcn_sched_barrier(0)
#define ATT_KLOAD(DST, GRP) do { _Pragma("unroll") for (int t_ = 0; t_ < 4; ++t_) { const int kb_ = (RBK_(2 * (GRP) + (t_ >> 1))) * 128 + klo_[t_ & 1]; \
        (DST)[t_][0] = *(const LAS bf16x8*)(kimg_ + kb_); (DST)[t_][1] = *(const LAS bf16x8*)(kimg_ + (kb_ ^ 64)); } } while (0)
#define ATT_QKMMA(SRC, GRP) do { _Pragma("unroll") for (int t_ = 0; t_ < 4; ++t_) s_[4 * (GRP) + t_] = __builtin_amdgcn_mfma_f32_16x16x32_bf16((SRC)[t_][0], qf0_, ATT_CINIT(4 * (GRP) + t_), 0, 0, 0); \
        _Pragma("unroll") for (int t_ = 0; t_ < 4; ++t_) s_[4 * (GRP) + t_] = __builtin_amdgcn_mfma_f32_16x16x32_bf16((SRC)[t_][1], qf1_, s_[4 * (GRP) + t_], 0, 0, 0); } while (0)
#define ATT_VLOAD(DST, KK) do { const int vb_ = (RBK_(KK)) * 128; _Pragma("unroll") for (int dt_ = 0; dt_ < 4; ++dt_) { (DST)[dt_][0] = tr_read(vimg_ + vb_ + vlo_[dt_]); (DST)[dt_][1] = tr_read(vimg_ + vb_ + vlo_[dt_] + 512); } } while (0)
#define ATT_PVMMA(SRC, KK) do { v4u pw_; pw_.x = pkbf(s_[2 * (KK)][0], s_[2 * (KK)][1]); pw_.y = pkbf(s_[2 * (KK)][2], s_[2 * (KK)][3]); pw_.z = pkbf(s_[2 * (KK) + 1][0], s_[2 * (KK) + 1][1]); pw_.w = pkbf(s_[2 * (KK) + 1][2], s_[2 * (KK) + 1][3]); \
        const bf16x8 pf_ = __builtin_bit_cast(bf16x8, pw_); \
        _Pragma("unroll") for (int dt_ = 0; dt_ < 4; ++dt_) { const bf16x8 vf_ = (bf16x8){(SRC)[dt_][0][0], (SRC)[dt_][0][1], (SRC)[dt_][0][2], (SRC)[dt_][0][3], (SRC)[dt_][1][0], (SRC)[dt_][1][1], (SRC)[dt_][1][2], (SRC)[dt_][1][3]}; \
            (O_)[dt_] = __builtin_amdgcn_mfma_f32_16x16x32_bf16(vf_, pf_, (O_)[dt_], 0, 0, 0); } \
        osum_ = __builtin_amdgcn_mfma_f32_16x16x32_bf16(ones_, pf_, osum_, 0, 0, 0); } while (0)
#define ATT_CORE_QK(KIMG, VIMG, FIXGRP, QF, NEGB) \
    const int g_ = lane >> 4, r_ = lane & 15, q_ = r_ >> 2, p_ = r_ & 3; \
    LAS const unsigned char* const kimg_ = (KIMG); LAS const unsigned char* const vimg_ = (VIMG); \
    const bf16x8 qf0_ = (QF)[0], qf1_ = (QF)[1]; const f32x4 negb_ = (f32x4){(NEGB), (NEGB), (NEGB), (NEGB)}; \
    int klo_[2], vlo_[4]; \
    { const int rb0_ = RBK_(0); \
      _Pragma("unroll") for (int hh = 0; hh < 2; ++hh) { const int Rl_ = 8 * (r_ >> 2) + 4 * hh + (r_ & 3); klo_[hh] = Rl_ * 128 + ((16 * g_) ^ (att_f(rb0_ + Rl_) << 5)); } \
      const int Rv_ = 8 * g_ + q_, f0_ = att_f(rb0_ + Rv_); \
      _Pragma("unroll") for (int dt = 0; dt < 4; ++dt) vlo_[dt] = Rv_ * 128 + 32 * (dt ^ f0_) + 8 * p_; } \
    f32x4 s_[16]; \
    { bf16x8 ka_[4][2], kb2_[4][2]; \
      ATT_KLOAD(ka_, 0); ATT_PRELOAD(0); \
      ATT_KLOAD(kb2_, 1); ATT_PRELOAD(1); ATT_SB(); ATT_QKMMA(ka_, 0); ATT_SB(); \
      ATT_KLOAD(ka_, 2);  ATT_PRELOAD(2); ATT_SB(); ATT_QKMMA(kb2_, 1); FIXGRP(0); ATT_SB(); \
      ATT_KLOAD(kb2_, 3); ATT_PRELOAD(3); ATT_SB(); ATT_QKMMA(ka_, 2); FIXGRP(1); ATT_SB(); \
      ATT_QKMMA(kb2_, 3); FIXGRP(2); FIXGRP(3); }
#define ATT_CORE_PV(O, LSUM) \
    f32x4 (&O_)[4] = (O); \
    s16x4 va_[4][2], vb2_[4][2]; \
    ATT_VLOAD(va_, 0); \
    _Pragma("unroll") for (int t = 0; t < 16; ++t) { _Pragma("unroll") for (int i = 0; i < 4; ++i) s_[t][i] = __builtin_amdgcn_exp2f(s_[t][i]); }     \
    const bf16x8 ones_ = (bf16x8){0x3F80, 0x3F80, 0x3F80, 0x3F80, 0x3F80, 0x3F80, 0x3F80, 0x3F80}; f32x4 osum_ = (f32x4){0.f, 0.f, 0.f, 0.f}; \
    _Pragma("unroll") for (int dt = 0; dt < 4; ++dt) O_[dt] = (f32x4){0.f, 0.f, 0.f, 0.f}; \
    ATT_VLOAD(vb2_, 1); ATT_SB(); ATT_PVMMA(va_, 0); ATT_SB(); \
    ATT_VLOAD(va_, 2);  ATT_SB(); ATT_PVMMA(vb2_, 1); ATT_SB(); \
    ATT_VLOAD(vb2_, 3); ATT_SB(); ATT_PVMMA(va_, 2); ATT_SB(); \
    ATT_VLOAD(va_, 4);  ATT_SB(); ATT_PVMMA(vb2_, 3); ATT_SB(); \
    ATT_VLOAD(vb2_, 5); ATT_SB(); ATT_PVMMA(va_, 4); ATT_SB(); \
    ATT_VLOAD(va_, 6);  ATT_SB(); ATT_PVMMA(vb2_, 5); ATT_SB(); \
    ATT_VLOAD(vb2_, 7); ATT_SB(); ATT_PVMMA(va_, 6); ATT_SB(); \
    ATT_PVMMA(vb2_, 7); (LSUM) = osum_[0];
#define ATT_CORE(KIMG, VIMG, FIXGRP, QF, NEGB, O, LSUM) do { ATT_CORE_QK(KIMG, VIMG, FIXGRP, QF, NEGB) ATT_CORE_PV(O, LSUM) } while (0)

__device__ __forceinline__ float att_qnorm(const bf16x8 (&qf)[2]) {
    float ss = 0.f;
#pragma unroll
    for (int k = 0; k < 2; ++k) { const v4u w = __builtin_bit_cast(v4u, qf[k]);
        const float a0 = bf_lo(w.x), a1 = bf_hi(w.x), a2 = bf_lo(w.y), a3 = bf_hi(w.y), a4 = bf_lo(w.z), a5 = bf_hi(w.z), a6 = bf_lo(w.w), a7 = bf_hi(w.w);
        ss += ((a0 * a0 + a1 * a1) + (a2 * a2 + a3 * a3)) + ((a4 * a4 + a5 * a5) + (a6 * a6 + a7 * a7)); }
    ss = pg8::red_add_g4(ss);
    return sqrtf(ss);
}
struct GateRegs { u32x2v w[4]; };
__device__ __forceinline__ void att_load_gate(const bf16* gate_row, int g, GateRegs& gt) {
#pragma unroll
    for (int dt = 0; dt < 4; ++dt) gt.w[dt] = *(const GAS u32x2v*)(gate_row + 16 * dt + 4 * g);
}
template <bool SILU>
__device__ __forceinline__ void att_epilogue(const f32x4 (&o)[4], float lsum, const GateRegs& gt, bf16* y_row, int g) {
    const float inv = __builtin_amdgcn_rcpf(lsum);
    unsigned w[4][2];
#pragma unroll
    for (int dt = 0; dt < 4; ++dt) { const float g0 = bf_lo(gt.w[dt].x), g1 = bf_hi(gt.w[dt].x), g2 = bf_lo(gt.w[dt].y), g3 = bf_hi(gt.w[dt].y);
        if constexpr (SILU) { w[dt][0] = pkbf(o[dt][0] * inv * silu_f(g0), o[dt][1] * inv * silu_f(g1)); w[dt][1] = pkbf(o[dt][2] * inv * silu_f(g2), o[dt][3] * inv * silu_f(g3)); }
        else { w[dt][0] = pkbf(o[dt][0] * inv * g0, o[dt][1] * inv * g1); w[dt][1] = pkbf(o[dt][2] * inv * g2, o[dt][3] * inv * g3); } }
#pragma unroll
    for (int pr = 0; pr < 2; ++pr) { const int A = 2 * pr, B = 2 * pr + 1;
        const auto s0 = __builtin_amdgcn_permlane16_swap(w[A][0], w[B][0], false, false); const auto s1 = __builtin_amdgcn_permlane16_swap(w[A][1], w[B][1], false, false);
        v4u ov; ov.x = s0[0]; ov.y = s1[0]; ov.z = s0[1]; ov.w = s1[1];
        *(GAS v4u*)(y_row + 16 * ((g & 1) ? B : A) + 8 * (g >> 1)) = ov; }
}

__device__ __forceinline__ int na_base(int rp) { int rs = 2 * rp - 4; rs = rs < 0 ? 0 : (rs > 56 ? 56 : rs); return rs < 55 ? rs : 55; }
template <int NRP>
__device__ __forceinline__ void natten_seq(Frame& F, int l, int b, int h, int rp0) {
    FRESH_LANES(F);
    const bf16* P = (const bf16*)(F.ws + WS_P); bf16* Y = (bf16*)(F.ws + WS_Y);
    const int w = F.wave, lane = F.lane, tid = F.tid;
    LAS unsigned char* Kimg = F.lds + ATT_K_OFF; LAS unsigned char* Vimg = F.lds + ATT_V_OFF; LAS float* bt = (LAS float*)(F.lds + ATT_BT_OFF);
    const bf16* Pk = pplane(P, S_BK, h) + (size_t)(b * SEQ) * 64;
    constexpr size_t KV = (size_t)(S_BV - S_BK) * 4 * PLANE;
    const float bshift = ((const float*)(F.ws + WS_BND))[8 * l + 6] * ((const float*)(F.ws + WS_BND))[8 * l + 0] + ((const float*)(F.ws + WS_BND))[8 * l + 2 + h];
    {
        const int base = na_base(rp0);
        v4u kv[9], vv[9];
#pragma unroll
        for (int j = 0; j < 9; ++j) { const int id = tid + 512 * j, key = id >> 3, c = id & 7; const bf16* src = Pk + (size_t)(base * 64 + key) * 64 + 8 * c; kv[j] = *(const GAS v4u*)src; vv[j] = *(const GAS v4u*)(src + KV); }
        if (tid < 15 * 32) { const int dr = tid >> 5, dc = tid & 31; bt[tid] = dc < 31 ? F.in[I_RPB][((l * 4 + h) * 15 + dr) * 31 + dc] * LOG2E - bshift : -1e30f; }
#pragma unroll
        for (int j = 0; j < 9; ++j) { const int id = tid + 512 * j, key = id >> 3, c = id & 7; const int arow = base + (key >> 6), col = key & 63;
            const int off = ((arow % 9) * 64 + col) * 128 + ((16 * c) ^ (att_f(col) << 5));
            *(LAS v4u*)(Kimg + off) = kv[j]; *(LAS v4u*)(Vimg + off) = vv[j]; }
    }
    const int g = lane >> 4, r = lane & 15, qg = w & 3;
    const int cb = (qg == 0) ? 0 : (qg == 1 ? 8 : (qg == 2 ? 24 : 32));
    const int cq = 16 * qg + r; int cs = cq - 8; cs = cs < 0 ? 0 : (cs > 48 ? 48 : cs);
    int bto[2][4];
#pragma unroll
    for (int hh = 0; hh < 2; ++hh)
#pragma unroll
        for (int i = 0; i < 4; ++i) { const int ck = cb + 8 * g + 4 * hh + i; bto[hh][i] = 4 * (((unsigned)(ck - cs) < 16u) ? (ck - cq + 15) : 31); }
    const float bnd_k = ((const float*)(F.ws + WS_BND))[8 * l + 0], bnd_b = ((const float*)(F.ws + WS_BND))[8 * l + 2 + h], bnd_q = ((const float*)(F.ws + WS_BND))[8 * l + 6];
    int hi_loaded = na_base(rp0) + 9;
    bf16x8 qf[2]; GateRegs gt;
    { const size_t tok = (size_t)(b * SEQ + (2 * rp0 + (w >> 2)) * 64 + cq);
      qf[0] = *(const GAS bf16x8*)(pplane(P, S_BQ, h) + tok * 64 + 8 * g); qf[1] = *(const GAS bf16x8*)(pplane(P, S_BQ, h) + tok * 64 + 32 + 8 * g); }
#pragma unroll 1
    for (int j = 0; j < NRP; ++j) {
        const int rp = rp0 + j, qrow = 2 * rp + (w >> 2);
        const size_t tok = (size_t)(b * SEQ + qrow * 64 + cq);

        att_load_gate(pplane(P, S_BG, h) + tok * 64, g, gt);
        __syncthreads();
        if (w >= 4) __builtin_amdgcn_s_sleep(10);

        int rs = qrow - 4; rs = rs < 0 ? 0 : (rs > 56 ? 56 : rs);
        const int dr0 = rs - qrow + 7;
        f32x4 o[4]; float lsum;
        LAS const unsigned char* const btrow = (LAS const unsigned char*)bt + dr0 * 128;
        const float negb = -(bnd_q * bnd_k + bnd_b);
        bf16x8 qn[2]; v4u pk[2], pv[2]; int nlo = 0, nnew = 0;
#define RBK_(KK) ((((rs + (KK)) % 9) * 64) + cb)
#define NA_FIXGRP(GRP) do { } while (0)
#define ATT_PRELOAD(GRP) do { _Pragma("unroll") for (int t_ = 0; t_ < 4; ++t_) { _Pragma("unroll") for (int i = 0; i < 4; ++i) \
            s_[4 * (GRP) + t_][i] = *(const LAS float*)(btrow + (2 * (GRP) + (t_ >> 1)) * 128 + bto[t_ & 1][i]); } } while (0)
#define ATT_CINIT(T) s_[T]
        {   ATT_CORE_QK(Kimg, Vimg, NA_FIXGRP, qf, negb)

            if (j + 1 < NRP) { const size_t tn = tok + 128;
                qn[0] = *(const GAS bf16x8*)(pplane(P, S_BQ, h) + tn * 64 + 8 * g); qn[1] = *(const GAS bf16x8*)(pplane(P, S_BQ, h) + tn * 64 + 32 + 8 * g);
                const int nb = na_base(rp + 1); nlo = hi_loaded > nb ? hi_loaded : nb; nnew = nb + 9 - nlo;
#pragma unroll
                for (int t = 0; t < 2; ++t) { const int id = tid + 512 * t, ri = id >> 9, col = (id >> 3) & 63, c = id & 7;
                    if (ri < nnew) { const bf16* src = Pk + (size_t)((nlo + ri) * 64 + col) * 64 + 8 * c; pk[t] = *(const GAS v4u*)src; pv[t] = *(const GAS v4u*)(src + KV); } } }
            ATT_CORE_PV(o, lsum) }

#undef NA_FIXGRP
#undef ATT_PRELOAD
#undef ATT_CINIT
#undef RBK_
        att_epilogue<false>(o, lsum, gt, Y + tok * DM + 256 + 64 * h, g);
        __syncthreads();
        if (j + 1 < NRP) {
#pragma unroll
            for (int t = 0; t < 2; ++t) { const int id = tid + 512 * t, ri = id >> 9, col = (id >> 3) & 63, c = id & 7;
                if (ri < nnew) { const int off = (((nlo + ri) % 9) * 64 + col) * 128 + ((16 * c) ^ (att_f(col) << 5)); *(LAS v4u*)(Kimg + off) = pk[t]; *(LAS v4u*)(Vimg + off) = pv[t]; } }
            hi_loaded = nlo + nnew;
            qf[0] = qn[0]; qf[1] = qn[1]; }
    }
}
__device__ __forceinline__ void memattn_unit(Frame& F, int l, int b, int h, int tb) {
    FRESH_LANES(F);
    const bf16* P = (const bf16*)(F.ws + WS_P); bf16* Y = (bf16*)(F.ws + WS_Y); const bf16* MKV = (const bf16*)(F.ws + WS_MKV);
    const int w = F.wave, lane = F.lane, tid = F.tid;
    LAS unsigned char* Kimg = F.lds + ATT_K_OFF; LAS unsigned char* Vimg = F.lds + ATT_V_OFF;
    const bf16* Mb = MKV + (size_t)(b * NMEM) * 1024 + l * 512 + 64 * h;
    const int g = lane >> 4, r = lane & 15;
    const size_t tok0 = (size_t)(b * SEQ + 512 * tb + 16 * w + r);
    const float bnd_k = ((const float*)(F.ws + WS_BND))[8 * l + 1], bnd_q = ((const float*)(F.ws + WS_BND))[8 * l + 7];
    bf16x8 qf[2]; GateRegs gt;
    { v4u kv[4], vv[4];
#pragma unroll
      for (int j = 0; j < 4; ++j) { const int id = tid + 512 * j, key = id >> 3, c = id & 7; const bf16* src = Mb + (size_t)key * 1024 + 8 * c; kv[j] = *(const GAS v4u*)src; vv[j] = *(const GAS v4u*)(src + 256); }
      qf[0] = *(const GAS bf16x8*)(pplane(P, S_DQ, h) + tok0 * 64 + 8 * g); qf[1] = *(const GAS bf16x8*)(pplane(P, S_DQ, h) + tok0 * 64 + 32 + 8 * g);
      att_load_gate(pplane(P, S_DG, h) + tok0 * 64, g, gt);
#pragma unroll
      for (int j = 0; j < 4; ++j) { const int id = tid + 512 * j, key = id >> 3, c = id & 7; const int off = key * 128 + ((16 * c) ^ (att_f(key) << 5));
          *(LAS v4u*)(Kimg + off) = kv[j]; *(LAS v4u*)(Vimg + off) = vv[j]; } }
    __syncthreads();
#pragma unroll 1
    for (int rnd = 0; rnd < 4; ++rnd) {
        const size_t tok = tok0 + 128 * rnd;
        bf16x8 qn[2]; GateRegs gn;
        if (rnd < 3) { const size_t tn = tok + 128;
            qn[0] = *(const GAS bf16x8*)(pplane(P, S_DQ, h) + tn * 64 + 8 * g); qn[1] = *(const GAS bf16x8*)(pplane(P, S_DQ, h) + tn * 64 + 32 + 8 * g);
            att_load_gate(pplane(P, S_DG, h) + tn * 64, g, gn); }
        f32x4 o[4]; float lsum;
#define RBK_(KK) (32 * (KK))
#define MA_FIXGRP(GRP) do { } while (0)
#define ATT_PRELOAD(GRP) do { } while (0)
#define ATT_CINIT(T) negb_
        const float negb = -(bnd_q * bnd_k);
        ATT_CORE(Kimg, Vimg, MA_FIXGRP, qf, negb, o, lsum);
#undef MA_FIXGRP
#undef ATT_PRELOAD
#undef ATT_CINIT
#undef RBK_
        att_epilogue<false>(o, lsum, gt, Y + tok * DM + 768 + 64 * h, g);
        if (rnd < 3) { qf[0] = qn[0]; qf[1] = qn[1]; gt = gn; }
    }
    __syncthreads();
}

constexpr int MKL_A_BYTES = 64 * 256, MKL_STAGE = MKL_A_BYTES + 128 * 256;
__device__ __forceinline__ void memkv_light(Frame& F) {
    FRESH_LANES(F);
    const bf16* memA = (const bf16*)(F.ws + WS_MEMA); const bf16* W = (const bf16*)(F.ws + WS_WMKV); bf16* MKV = (bf16*)(F.ws + WS_MKV);
    const int lane = F.lane, tid = F.tid, g = lane >> 4, r = lane & 15, tg = F.wave & 3, hd = F.wave >> 2;
    for (int u = F.vcu; u < 256; u += F.G) {
        const int b = u >> 5, tq = (u & 31) >> 3, nq = u & 7, rowt = b * NMEM + 64 * tq, nt0 = 128 * nq;
        v4u RA[6], RB[6];
#define MKL_ISSUE(R, C) do { _Pragma("unroll") for (int j = 0; j < 6; ++j) { const int id = tid + 512 * j; \
            if (j < 2) (R)[j] = *(const GAS v4u*)(memA + (size_t)(rowt + (id >> 4)) * 1024 + 128 * (C) + 8 * (id & 15)); \
            else { const int i2 = id - 1024; (R)[j] = *(const GAS v4u*)(W + (size_t)(nt0 + (i2 >> 4)) * 1024 + 128 * (C) + 8 * (i2 & 15)); } } } while (0)
#define MKL_COMMIT(R, ST) do { LAS unsigned char* sa_ = F.lds + (ST) * MKL_STAGE; _Pragma("unroll") for (int j = 0; j < 6; ++j) { const int id = tid + 512 * j; \
            if (j < 2) { const int row = id >> 4, ch = id & 15; *(LAS v4u*)(sa_ + row * 256 + ((ch ^ (row & 15)) << 4)) = (R)[j]; } \
            else { const int i2 = id - 1024, row = i2 >> 4, ch = i2 & 15; *(LAS v4u*)(sa_ + MKL_A_BYTES + row * 256 + ((ch ^ (row & 15)) << 4)) = (R)[j]; } } } while (0)
#define MKL_COMPUTE(ST) do { LAS const unsigned char* sa = F.lds + (ST) * MKL_STAGE; const int arow = 16 * tg + r; \
            _Pragma("unroll") for (int ks = 0; ks < 4; ++ks) { const bf16x8 af = *(const LAS bf16x8*)(sa + arow * 256 + (((4 * ks + g) ^ r) << 4)); \
                _Pragma("unroll") for (int mt = 0; mt < 4; ++mt) { const int wrow = 64 * hd + 16 * mt + r; \
                    const bf16x8 wf = *(const LAS bf16x8*)(sa + MKL_A_BYTES + wrow * 256 + (((4 * ks + g) ^ r) << 4)); \
                    acc[mt] = __builtin_amdgcn_mfma_f32_16x16x32_bf16(wf, af, acc[mt], 0, 0, 0); } } } while (0)
        f32x4 acc[4];
#pragma unroll
        for (int mt = 0; mt < 4; ++mt) acc[mt] = (f32x4){0.f, 0.f, 0.f, 0.f};
        MKL_ISSUE(RA, 0); MKL_ISSUE(RB, 1); MKL_COMMIT(RA, 0);
        __syncthreads();
#pragma unroll 1
        for (int c2 = 0; c2 < 8; c2 += 2) {
            if (c2 + 2 < 8) MKL_ISSUE(RA, c2 + 2);
            MKL_COMPUTE(0);
            MKL_COMMIT(RB, 1);
            __syncthreads();
            if (c2 + 3 < 8) MKL_ISSUE(RB, c2 + 3);
            MKL_COMPUTE(1);
            if (c2 + 2 < 8) MKL_COMMIT(RA, 0);
            __syncthreads();
        }
#undef MKL_COMPUTE
#undef MKL_ISSUE
#undef MKL_COMMIT
        const int row0 = rowt + 16 * tg, n0 = nt0 + 64 * hd;
        const int l = n0 >> 9; const bool isk = (n0 & 256) == 0;
        float hr = 1.0f;
        if (isk) { float ss = 0.f;
#pragma unroll
            for (int mt = 0; mt < 4; ++mt) ss += (acc[mt][0] * acc[mt][0] + acc[mt][1] * acc[mt][1]) + (acc[mt][2] * acc[mt][2] + acc[mt][3] * acc[mt][3]);
            ss = pg8::red_add_g4(ss); hr = __builtin_amdgcn_rsqf(ss * (1.0f / 64.0f) + 1e-6f); }
#pragma unroll
        for (int mt = 0; mt < 4; ++mt) { f32x4 v = acc[mt] * hr;
            if (isk) { const f32x4 gn = *(const GAS f32x4*)(F.in[I_MK] + 64 * l + 16 * mt + 4 * g); v = v * gn; }
            store4bf(MKV + (size_t)(row0 + r) * 1024 + n0 + 16 * mt + 4 * g, v[0], v[1], v[2], v[3]); }
    }
}

constexpr int CW_GB = 8192;
#define GB_SUB(j) (CW_GB + 64 * (j))
#define GB_GEN(j) (CW_GB + 64 * (16 + (j)))
__device__ __forceinline__ void group_barrier(unsigned* ctl, unsigned x, unsigned* tmo) {
    asm volatile("s_waitcnt vmcnt(0)" ::: "memory");
    __syncthreads();
    if (threadIdx.x == 0) {
        __builtin_amdgcn_fence(__ATOMIC_ACQUIRE, "agent");
        const unsigned old = xb_add(&ctl[GB_SUB(x)], 1u);
        const unsigned gen = old >> 5;
        if ((old & 31u) == 31u) xb_add(&ctl[GB_GEN(x)], 1u);
        else XB_SPIN(xb_ld(&ctl[GB_GEN(x)]) == gen, tmo - XB_TMO);
        asm volatile("s_waitcnt vmcnt(0)" ::: "memory");
    }
    __syncthreads();
}

#define GB_FLAG(j) (CW_GB + 64 * (32 + (j)))
__device__ __forceinline__ void seam_arrive(unsigned* ctl, unsigned g, bool fast) {
    asm volatile("s_waitcnt vmcnt(0)" ::: "memory");
    __syncthreads();
    if (threadIdx.x == 0) {
        if (!fast) { __builtin_amdgcn_fence(__ATOMIC_RELEASE, "agent"); asm volatile("s_waitcnt vmcnt(0)" ::: "memory"); }
        xb_add(&ctl[GB_FLAG(fast ? g : 0u)], 1u);
    }
}
__device__ __forceinline__ void seam_wait(unsigned* ctl, unsigned g, bool fast, unsigned target, unsigned* tmo) {
    if (threadIdx.x == 0) {
        XB_SPIN(xb_ld(&ctl[GB_FLAG(fast ? g : 0u)]) < target, tmo - XB_TMO);
        if (!fast) { __builtin_amdgcn_fence(__ATOMIC_ACQUIRE, "agent"); asm volatile("s_waitcnt vmcnt(0)" ::: "memory"); }
    }
    __syncthreads();
}

constexpr int N_PHASES = 7;
struct Args { const float* in[17]; float* out; unsigned char* ws; int ph_lo, ph_hi; };
__global__ void __launch_bounds__(NWAVES * 64, 2) mk_fwd(Args args) {
    extern __shared__ __attribute__((aligned(16))) unsigned char lds[];
    Frame F;
    F.lds = (LAS unsigned char*)lds;
    F.MISC = (volatile LAS unsigned*)(F.lds + MISC_OFF);
    F.tid = threadIdx.x; F.lane = F.tid & 63; F.wave = __builtin_amdgcn_readfirstlane(F.tid >> 6);
    F.G = gridDim.x; { const int bx = blockIdx.x; F.vcu = (F.G % 8 == 0) ? (bx % 8) * (F.G / 8) + bx / 8 : bx; }
    F.ws = args.ws; F.out = args.out; F.ctl = (gu32*)(args.ws + WS_CTL);
    F.in = (kargtab)__builtin_amdgcn_kernarg_segment_ptr();
    for (int u = F.tid; u < (LDS_BYTES - LDSCTL_OFF) / 4; u += NWAVES * 64) ((LAS unsigned*)(F.lds + LDSCTL_OFF))[u] = 0u;
    __syncthreads();
    const int lo = args.ph_lo, hi = args.ph_hi;
    const bool one_launch = (hi - lo) > 1;
    XcdBarrier bar; bar.bar = (unsigned*)(F.ctl + CW_BAR); bar.x = 0; bar.st = nullptr;
    if (one_launch) {
        bar.bar = (unsigned*)(F.ctl + CW_BAR); bar.x = xb_xcc_id(); bar.st = F.MISC + 8;
        if (F.tid == 0) F.MISC[10] = xb_add(&bar.bar[XB_XCNT(bar.x)], 1u);
    }
    bool fast = false; int cidx = (int)blockIdx.x;


    for (int ph = lo; ph < hi; ++ph) {
      {
        if (ph == 0) { p0_prologue(F); __syncthreads(); }
        else {
            const int l = (ph - 1) / 3, k = (ph - 1) % 3;
            FRESH_BASES(F);
            bf16* WinT = (bf16*)(F.ws + WS_WIN); bf16* WoutT = (bf16*)(F.ws + WS_WOUT);
            bf16* XB = (bf16*)(F.ws + WS_XB); bf16* PB = (bf16*)(F.ws + WS_P); bf16* YB = (bf16*)(F.ws + WS_Y); float* PART = (float*)(F.ws + WS_PART);
            if (k == 0) {
                if (l == 0) memkv_light(F);
                {
                    pg8::Gemm g{XB, WinT + (size_t)l * NPROJ * 1024, MTOK, NPROJ, 1024};
                    LAS float* rs_tab = (LAS float*)(F.lds + 131072);
                    const int rs_row = ((cidx & 7) * 16 + ((cidx >> 3) & 7) + 8 * (F.tid >> 8)) * 256 + (F.tid & 255);
                    pg8::EpiProj E{PB, MTOK, S_XC, S_XS, PART, F.in[I_NAQ] + 64 * l, F.in[I_NAK] + 64 * l, F.in[I_MQ] + 64 * l, S_BQ, S_BK, S_DQ, QSCALE, 1.f, QSCALE, (1u << S_DG) | (1u << S_BG), fast ? (const LAS float*)rs_tab : (const LAS float*)nullptr, fast ? PART + (size_t)rs_row * 16 : (const float*)nullptr, rs_tab + F.tid};
                    pg8::StaticOrder S; S.init(MTOK, NPROJ, F.G, cidx, 2);
                    pg8::gemm_phase<pg8::EpiProj, pg8::StaticOrder, true, true>(F.lds, g, S, E, F.wave);
                }
            } else if (k == 1) {
                for (int u = F.vcu; u < 256; u += F.G) spatial_seq(F, l, u);
                seam_arrive((unsigned*)F.ctl, bar.x, fast);
                for (int u = F.vcu; u < 256; u += F.G) natten_seq<4>(F, l, u >> 5, (u & 31) >> 3, 4 * (u & 7));
                for (int u = F.vcu; u < 256; u += F.G) memattn_unit(F, l, u >> 5, (u & 31) >> 3, u & 7);
                seam_wait((unsigned*)F.ctl, bar.x, fast, (fast ? 32u : (unsigned)F.G) * (unsigned)(l + 1), bar.bar + XB_TMO);
                for (int u = F.vcu; u < 256; u += F.G) fft2_seq(F, u);
            } else {
                pg8::Gemm g{YB, WoutT + (size_t)l * 1024 * 1024, MTOK, DM, 1024};
                pg8::EpiOut E{XB, F.out, l == 0 ? XB : nullptr, PART, DM};
                pg8::StaticOrder S; S.init(MTOK, DM, F.G, cidx);
                pg8::gemm_phase<pg8::EpiOut, pg8::StaticOrder, true, true>(F.lds, g, S, E, F.wave);
            }
        }
      }
        if (ph + 1 < hi) {
            if (fast) group_barrier((unsigned*)F.ctl, bar.x, bar.bar + XB_TMO);
            else xcd_barrier(bar);
            if (one_launch && ph == lo) {
                fast = __builtin_amdgcn_readfirstlane((int)F.MISC[11]) != 0;
                if (fast) { const int rank = __builtin_amdgcn_readfirstlane((int)F.MISC[12]), slot = __builtin_amdgcn_readfirstlane((int)F.MISC[10]); F.vcu = rank * 32 + slot; cidx = slot * 8 + rank; }
                __syncthreads();
            }
        }
    }
}

#ifndef MK_N_LAUNCHES
#define MK_N_LAUNCHES 1
#endif
extern "C" void kernel_launch(void* const* d_in, const int* in_sizes, int n_in, void* d_out, int out_size, void* d_ws, size_t ws_size, hipStream_t stream) {
    static int grid = 0;
    if (grid == 0) {
        if (n_in != 17 || in_sizes[0] != MTOK * DM || out_size != MTOK * DM || ws_size < WS_END) { fprintf(stderr, "kernel_launch: unexpected shapes (n_in %d, in0 %d, out %d, ws %zu); nothing launched\n", n_in, n_in > 0 ? in_sizes[0] : -1, out_size, ws_size); grid = -1; return; }
        int dev = 0, cus = 0, per_cu = 0;
        if (hipGetDevice(&dev) != hipSuccess || hipDeviceGetAttribute(&cus, hipDeviceAttributeMultiprocessorCount, dev) != hipSuccess) { fprintf(stderr, "kernel_launch: device query failed\n"); grid = -1; return; }
        if (hipFuncSetAttribute((const void*)mk_fwd, hipFuncAttributeMaxDynamicSharedMemorySize, LDS_BYTES) != hipSuccess) { fprintf(stderr, "kernel_launch: hipFuncSetAttribute failed\n"); grid = -1; return; }
        if (hipOccupancyMaxActiveBlocksPerMultiprocessor(&per_cu, (const void*)mk_fwd, NWAVES * 64, LDS_BYTES) != hipSuccess || per_cu < 1)
            fprintf(stderr, "kernel_launch: note: occupancy query reports %d workgroups per CU\n", per_cu);
        (void)hipGetLastError();
        grid = cus;
    }
    if (grid < 0) return;
    if (hipMemsetAsync((char*)d_ws + WS_CTL, 0, CTL_ZERO_BYTES, stream) != hipSuccess) { fprintf(stderr, "kernel_launch: memset failed\n"); return; }
    Args a{};
    for (int i = 0; i < 17; ++i) a.in[i] = (const float*)d_in[i];
    a.out = (float*)d_out; a.ws = (unsigned char*)d_ws;
#if MK_N_LAUNCHES == 1
    a.ph_lo = 0; a.ph_hi = N_PHASES;
    hipLaunchKernelGGL(mk_fwd, dim3(grid), dim3(NWAVES * 64), LDS_BYTES, stream, a);
#else
    for (int ph = 0; ph < N_PHASES; ++ph) { a.ph_lo = ph; a.ph_hi = ph + 1; hipLaunchKernelGGL(mk_fwd, dim3(grid), dim3(NWAVES * 64), LDS_BYTES, stream, a); }
#endif
    const hipError_t le = hipPeekAtLastError();
    if (le != hipSuccess) fprintf(stderr, "kernel_launch: launch failed: %s\n", hipGetErrorName(le));
}
```
